# Optimizing an MI355X kernel written in HIP

```python
import math
import jax, jax.numpy as jnp
from jax import lax
import numpy as np

D_MODEL = 1024
BATCH = 2
SEQ = 16384
DEPTH = 4

HEAD_DIM = 64
GRID_W = 64
Q_BLOCK = 128
RMS_EPS = 1e-6
LN_EPS = 1e-5
A_HEADS = 4
A_KV_HEADS = 2
A_GROUP = A_HEADS // A_KV_HEADS
ROPE_THETA = 10000.0
B_HEADS = 4
B_QK_DIM = HEAD_DIM // 2
C_HEADS = 4
NA_ROWS = 8
NA_COLS = 16
D_GROUPS = 4
D_CHUNK = 128
D_WIDTH = D_GROUPS * HEAD_DIM
FFN_DIM = -(-8 * D_MODEL // (3 * 256)) * 256
PLE_DIM = 256

A_Q = A_HEADS * HEAD_DIM
A_KV = A_KV_HEADS * HEAD_DIM
B_QK = B_HEADS * 2 * B_QK_DIM
B_V = B_HEADS * HEAD_DIM
C_W = C_HEADS * HEAD_DIM
MIX_WIDTH = A_Q + B_V + C_W + D_WIDTH
PROJ_SPLITS = (A_Q, A_KV, A_KV, B_QK, B_QK, B_V, C_W, C_W, C_W, 2 * D_WIDTH)
PROJ_WIDTH = A_Q + 2 * A_KV + 2 * B_QK + B_V + 3 * C_W + 2 * D_WIDTH

kernel_name = 'hybrid_parallel_mixer_encoder'


def rms_norm(x, g, eps=RMS_EPS):
    xf = x.astype(jnp.float32)
    y = xf * lax.rsqrt(jnp.mean(xf * xf, axis=-1, keepdims=True) + eps)
    return (y * g.astype(jnp.float32)).astype(x.dtype)


def layer_norm(x, g, b, eps=LN_EPS):
    xf = x.astype(jnp.float32)
    mu = jnp.mean(xf, axis=-1, keepdims=True)
    xc = xf - mu
    y = xc * lax.rsqrt(jnp.mean(xc * xc, axis=-1, keepdims=True) + eps)
    return (y * g.astype(jnp.float32) + b.astype(jnp.float32)).astype(x.dtype)


def split_cols(y, sizes):
    outs, start = [], 0
    for n in sizes:
        outs.append(y[..., start:start + n])
        start += n
    return outs


def to_blocks(x):
    b, s = x.shape[:2]
    return jnp.swapaxes(x.reshape(b, s // Q_BLOCK, Q_BLOCK, *x.shape[2:]), 0, 1)


def from_blocks(y):
    y = jnp.swapaxes(y, 0, 1)
    return y.reshape(y.shape[0], -1, *y.shape[3:])


def axial_rope_tables(seq_len):
    t = jnp.arange(seq_len)
    row = (t // GRID_W).astype(jnp.float32)
    col = (t % GRID_W).astype(jnp.float32)
    n_freq = HEAD_DIM // 4
    inv = ROPE_THETA ** (-jnp.arange(n_freq, dtype=jnp.float32) / n_freq)
    ang = jnp.concatenate([row[:, None] * inv, col[:, None] * inv], axis=-1)
    return jnp.cos(ang), jnp.sin(ang)


def apply_rope(x, cos, sin):
    xf = x.astype(jnp.float32)
    half = HEAD_DIM // 2
    x1, x2 = xf[..., :half], xf[..., half:]
    c, s = cos[None, :, None, :], sin[None, :, None, :]
    return jnp.concatenate([x1 * c - x2 * s, x2 * c + x1 * s], axis=-1).astype(x.dtype)


def alibi_slopes(n):
    start = 2.0 ** (-8.0 / n)
    return start ** jnp.arange(1, n + 1, dtype=jnp.float32)


def gqa_axial_attention(q, k, v):
    b, s, _, dh = q.shape
    cos, sin = axial_rope_tables(s)
    q = apply_rope(q, cos, sin)
    k = apply_rope(k, cos, sin)
    qb = to_blocks(q.reshape(b, s, A_KV_HEADS, A_GROUP, dh) * (dh ** -0.5))

    def step(q_blk):
        sc = jnp.einsum('bqkgd,bskd->bkgqs', q_blk, k).astype(jnp.float32)
        pr = jax.nn.softmax(sc, axis=-1).astype(v.dtype)
        return jnp.einsum('bkgqs,bskd->bqkgd', pr, v)

    o = from_blocks(lax.map(step, qb))
    return o.reshape(b, s, A_HEADS * dh)


def diff_attention(q, k, v, lam, lam_init, g_sub):
    b, s = q.shape[:2]
    pos = jnp.arange(s, dtype=jnp.float32)
    slopes = alibi_slopes(B_HEADS)
    qb = to_blocks(q * (B_QK_DIM ** -0.5))
    pb = pos.reshape(s // Q_BLOCK, Q_BLOCK)

    def step(args):
        q_blk, q_pos = args
        sc = jnp.einsum('bqhmd,bshmd->bhmqs', q_blk, k).astype(jnp.float32)
        dist = jnp.abs(q_pos[:, None] - pos[None, :])
        sc = sc - slopes[None, :, None, None, None] * dist[None, None, None]
        pr = jax.nn.softmax(sc, axis=-1)
        a = pr[:, :, 0] - lam * pr[:, :, 1]
        return jnp.einsum('bhqs,bshd->bqhd', a.astype(v.dtype), v)

    o = from_blocks(lax.map(step, (qb, pb)))
    o = rms_norm(o, g_sub) * (1.0 - lam_init)
    return o.reshape(b, s, B_HEADS * HEAD_DIM)


def neighbourhood_attention(q, k, v, rpb):
    b, s, h, dh = q.shape
    rows = s // GRID_W
    wr = min(NA_ROWS, rows)
    qg = q.reshape(b, rows, GRID_W, h, dh).transpose(1, 0, 3, 2, 4)
    kg = k.reshape(b, rows, GRID_W, h, dh).transpose(0, 3, 1, 2, 4)
    vg = v.reshape(b, rows, GRID_W, h, dh).transpose(0, 3, 1, 2, 4)
    cols = jnp.arange(GRID_W)
    cs = jnp.clip(cols - NA_COLS // 2, 0, GRID_W - NA_COLS)
    col_idx = cs[:, None] + jnp.arange(NA_COLS)[None, :]
    dc = col_idx - cols[:, None] + (NA_COLS - 1)
    scale = dh ** -0.5

    def row_block(args):
        r, q_r = args
        rs = jnp.clip(r - wr // 2, 0, rows - wr)
        k_band = lax.dynamic_slice_in_dim(kg, rs, wr, axis=2)
        v_band = lax.dynamic_slice_in_dim(vg, rs, wr, axis=2)
        k_nb = k_band[:, :, :, col_idx, :]
        v_nb = v_band[:, :, :, col_idx, :]
        sc = jnp.einsum('bhqd,bhrqcd->bhqrc', q_r * scale, k_nb).astype(jnp.float32)
        dr = rs + jnp.arange(wr) - r + (NA_ROWS - 1)
        bias = rpb[:, dr[:, None, None], dc[None, :, :]]
        sc = sc + bias.transpose(0, 2, 1, 3).astype(jnp.float32)[None]
        pr = jax.nn.softmax(sc.reshape(b, h, GRID_W, wr * NA_COLS), axis=-1)
        pr = pr.reshape(b, h, GRID_W, wr, NA_COLS).astype(v.dtype)
        return jnp.einsum('bhqrc,bhrqcd->bhqd', pr, v_nb)

    o = lax.map(row_block, (jnp.arange(rows), qg))
    return o.transpose(1, 0, 3, 2, 4).reshape(b, s, h * dh)


def spatial_gating(uv, ln_g, ln_b, w_s, b_s):
    z = jax.nn.gelu(uv, approximate=False)
    u, vv = z[..., :D_WIDTH], z[..., D_WIDTH:]
    vv = layer_norm(vv, ln_g, ln_b)
    b, s, c = vv.shape
    vv = vv.reshape(b, s // D_CHUNK, D_CHUNK, D_GROUPS, c // D_GROUPS)
    sv = jnp.einsum('gts,bnsgc->bntgc', w_s, vv) + b_s.T[None, None, :, :, None]
    return u * sv.reshape(b, s, c)


def setup_inputs(seed: int = 0) -> dict:
    key = jax.random.key(seed)
    ks = jax.random.split(key, 24)
    f32 = jnp.float32
    nrm = lambda k, shape, sc: jax.random.normal(k, shape, f32) * sc
    gain = lambda k, shape: 1.0 + 0.02 * jax.random.normal(k, shape, f32)
    L = DEPTH
    return {
        'x': nrm(ks[0], (BATCH, SEQ, D_MODEL), 1.0),
        'p': nrm(ks[1], (DEPTH, BATCH, SEQ, PLE_DIM), 1.0),
        'g_mix': gain(ks[2], (L, D_MODEL)),
        'w_in': nrm(ks[3], (L, D_MODEL, PROJ_WIDTH), D_MODEL ** -0.5),
        'a_q_norm': gain(ks[4], (L, HEAD_DIM)),
        'a_k_norm': gain(ks[5], (L, HEAD_DIM)),
        'b_lam_q': nrm(ks[6], (L, 2, B_QK_DIM), 0.1),
        'b_lam_k': nrm(ks[7], (L, 2, B_QK_DIM), 0.1),
        'b_sub_norm': gain(ks[8], (L, HEAD_DIM)),
        'c_rpb': nrm(ks[9], (L, C_HEADS, 2 * NA_ROWS - 1, 2 * NA_COLS - 1), 0.1),
        'd_ln_g': gain(ks[10], (L, D_WIDTH)),
        'd_ln_b': nrm(ks[11], (L, D_WIDTH), 0.02),
        'd_w_s': nrm(ks[12], (L, D_GROUPS, D_CHUNK, D_CHUNK), D_CHUNK ** -0.5),
        'd_b_s': 1.0 + nrm(ks[13], (L, D_GROUPS, D_CHUNK), 0.1),
        'w_out': nrm(ks[14], (L, MIX_WIDTH, D_MODEL), MIX_WIDTH ** -0.5),
        'g_ffn': gain(ks[15], (L, D_MODEL)),
        'w_gate': nrm(ks[16], (L, D_MODEL, FFN_DIM), D_MODEL ** -0.5),
        'w_up': nrm(ks[17], (L, D_MODEL, FFN_DIM), D_MODEL ** -0.5),
        'w_down': nrm(ks[18], (L, FFN_DIM, D_MODEL), FFN_DIM ** -0.5),
        'g_ple': gain(ks[19], (L, D_MODEL)),
        'w_ple_gate': nrm(ks[20], (L, D_MODEL, D_MODEL), D_MODEL ** -0.5),
        'w_ple_proj': nrm(ks[21], (L, PLE_DIM, D_MODEL), PLE_DIM ** -0.5),
        'g_final': gain(ks[22], (D_MODEL,)),
    }


def reference(x, p, g_mix, w_in, a_q_norm, a_k_norm, b_lam_q, b_lam_k, b_sub_norm,
              c_rpb, d_ln_g, d_ln_b, d_w_s, d_b_s, w_out, g_ffn, w_gate, w_up, w_down,
              g_ple, w_ple_gate, w_ple_proj, g_final):
    b, s, _ = x.shape
    h = x
    for i in range(DEPTH):
        hn = rms_norm(h, g_mix[i])
        proj = hn @ w_in[i]
        aq, ak, av, bq, bk, bv, cq, ck, cv, duv = split_cols(proj, PROJ_SPLITS)

        aq = rms_norm(aq.reshape(b, s, A_HEADS, HEAD_DIM), a_q_norm[i])
        ak = rms_norm(ak.reshape(b, s, A_KV_HEADS, HEAD_DIM), a_k_norm[i])
        av = av.reshape(b, s, A_KV_HEADS, HEAD_DIM)
        ya = gqa_axial_attention(aq, ak, av)

        lam_init = 0.8 - 0.6 * math.exp(-0.3 * i)
        lq = b_lam_q[i].astype(jnp.float32)
        lk = b_lam_k[i].astype(jnp.float32)
        lam = jnp.exp(jnp.sum(lq[0] * lk[0])) - jnp.exp(jnp.sum(lq[1] * lk[1])) + lam_init
        yb = diff_attention(bq.reshape(b, s, B_HEADS, 2, B_QK_DIM),
                            bk.reshape(b, s, B_HEADS, 2, B_QK_DIM),
                            bv.reshape(b, s, B_HEADS, HEAD_DIM),
                            lam, lam_init, b_sub_norm[i])

        yc = neighbourhood_attention(cq.reshape(b, s, C_HEADS, HEAD_DIM),
                                     ck.reshape(b, s, C_HEADS, HEAD_DIM),
                                     cv.reshape(b, s, C_HEADS, HEAD_DIM), c_rpb[i])

        yd = spatial_gating(duv, d_ln_g[i], d_ln_b[i], d_w_s[i], d_b_s[i])

        mix = jnp.concatenate([ya, yb, yc, yd], axis=-1)
        h = h + mix @ w_out[i]

        hn = rms_norm(h, g_ffn[i])
        h = h + (jax.nn.silu(hn @ w_gate[i]) * (hn @ w_up[i])) @ w_down[i]

        gate = jax.nn.sigmoid(rms_norm(h, g_ple[i]) @ w_ple_gate[i])
        h = h + gate * (p[i] @ w_ple_proj[i])
    return rms_norm(h, g_final)
```

```cpp
#include <hip/hip_runtime.h>
#include <hip/hip_cooperative_groups.h>
#include <cstdio>
#include <cstdint>
namespace cg = cooperative_groups;

typedef unsigned short bf16_t;
typedef short bf16x8 __attribute__((ext_vector_type(8)));
typedef float f32x16 __attribute__((ext_vector_type(16)));
typedef float f32x4 __attribute__((ext_vector_type(4)));
typedef float f32x2 __attribute__((ext_vector_type(2)));
typedef unsigned u32x4 __attribute__((ext_vector_type(4)));
typedef unsigned u32x2 __attribute__((ext_vector_type(2)));
typedef __bf16 bf2_t __attribute__((ext_vector_type(2)));
#define DI __device__ __forceinline__
#define MFMA(a, b, c) __builtin_amdgcn_mfma_f32_32x32x16_bf16((a), (b), (c), 0, 0, 0)

constexpr int SEQ = 16384, NTOK = 32768, DM = 1024, DEPTH = 4, FFN = 2816, PROJ = 2560, PLE = 256;
#ifndef MIXMASK
#define MIXMASK 15
#endif
constexpr float LOG2E = 1.4426950408889634f;
constexpr size_t MiB = 1u << 20;
constexpr size_t WL_IN = 0, WL_OUT = WL_IN + (size_t)PROJ * DM, WL_GU = WL_OUT + (size_t)DM * DM, WL_DOWN = WL_GU + (size_t)2 * FFN * DM,
                 WL_PG = WL_DOWN + (size_t)DM * FFN, WL_PP = WL_PG + (size_t)DM * DM, WL_TOT = WL_PP + (size_t)DM * PLE;
static_assert(WL_TOT * 2 == 26 * MiB, "weights per layer");
constexpr size_t OFF_W = 0, OFF_HB0 = 104 * MiB, OFF_HB1 = 168 * MiB, OFF_R = 232 * MiB, OFF_ROWSS = 488 * MiB, OFF_WS = 494 * MiB, OFF_ROPE = 495 * MiB;
constexpr size_t R_QA = 0, R_KA = 16 * MiB, R_VA = 24 * MiB, R_QB = 32 * MiB, R_KB = 48 * MiB, R_VB = 64 * MiB, R_QC = 80 * MiB, R_KC = 96 * MiB,
                 R_VC = 112 * MiB, R_UD = 128 * MiB, R_VD = 144 * MiB, R_MIX = 160 * MiB, R_STASH = 224 * MiB, R_ACT = 0;

struct KP { const float* in[23]; float* out; unsigned char* ws; };

DI unsigned pk2(float a, float b) { f32x2 v = {a, b}; bf2_t r = __builtin_convertvector(v, bf2_t); return __builtin_bit_cast(unsigned, r); }
DI bf16_t f2bf(float a) { __bf16 r = (__bf16)a; return __builtin_bit_cast(bf16_t, r); }
DI float bf2f(bf16_t v) { return __uint_as_float(((unsigned)v) << 16); }
DI float half_sum(float v) { v += __shfl_xor(v, 1); v += __shfl_xor(v, 2); v += __shfl_xor(v, 4); v += __shfl_xor(v, 8); v += __shfl_xor(v, 16); return v; }
DI int otid() { int t = threadIdx.x; asm volatile("" : "+v"(t) :: "memory"); return t; }
DI float opq(float x) { int u = __builtin_amdgcn_readfirstlane(__float_as_int(x)); asm volatile("" : "+s"(u)); return __int_as_float(u); }
DI float row_reduce32(float (&v)[32], int ln) {
#pragma unroll
    for (int j = 0; j < 16; ++j) { const bool up = (ln & 16) != 0; const float send = up ? v[j] : v[j + 16], keep = up ? v[j + 16] : v[j]; v[j] = keep + __shfl_xor(send, 16); }
#pragma unroll
    for (int j = 0; j < 8; ++j) { const bool up = (ln & 8) != 0; const float send = up ? v[j] : v[j + 8], keep = up ? v[j + 8] : v[j]; v[j] = keep + __shfl_xor(send, 8); }
#pragma unroll
    for (int j = 0; j < 4; ++j) { const bool up = (ln & 4) != 0; const float send = up ? v[j] : v[j + 4], keep = up ? v[j + 4] : v[j]; v[j] = keep + __shfl_xor(send, 4); }
#pragma unroll
    for (int j = 0; j < 2; ++j) { const bool up = (ln & 2) != 0; const float send = up ? v[j] : v[j + 2], keep = up ? v[j + 2] : v[j]; v[j] = keep + __shfl_xor(send, 2); }
    { const bool up = (ln & 1) != 0; const float send = up ? v[0] : v[1], keep = up ? v[1] : v[0]; v[0] = keep + __shfl_xor(send, 1); }
    return v[0];
}
DI int crow(int i, int hh) { return (i & 3) + 8 * (i >> 2) + 4 * hh; }

constexpr int LDT = 72;
constexpr int TILE_E = 128 * LDT;
constexpr int LDS_BYTES = 4 * TILE_E * 2;

template <bool AF32>
DI void gemm_kloop(const void* __restrict__ Ap, int lda, const bf16_t* __restrict__ Bt, int ldb, int K, int m0, int n0, f32x16 (&acc)[2][2], bf16_t* lds,
                   u32x4 (&ra)[4], u32x4 (&rb)[4], bool pre, bool nxt, int m0n, int n0n) {
    const int tid = otid(), lane = tid & 63, w = __builtin_amdgcn_readfirstlane(tid >> 6), wr = w >> 1, wc = w & 1;
    const int lr = tid >> 3, lc = (tid & 7) * 8;
#pragma unroll
    for (int mi = 0; mi < 2; ++mi)
#pragma unroll
        for (int ni = 0; ni < 2; ++ni)
#pragma unroll
            for (int i = 0; i < 16; ++i) acc[mi][ni][i] = 0.f;
    auto compute = [&](int buf) {
        const bf16_t* As = lds + buf * TILE_E + (wr * 64 + (lane & 31)) * LDT + (lane >> 5) * 8;
        const bf16_t* Bs = lds + (2 + buf) * TILE_E + (wc * 64 + (lane & 31)) * LDT + (lane >> 5) * 8;
#pragma unroll
        for (int ks = 0; ks < 4; ++ks) {
            const bf16x8 a0 = *(const bf16x8*)(As + ks * 16), a1 = *(const bf16x8*)(As + 32 * LDT + ks * 16);
            const bf16x8 b0 = *(const bf16x8*)(Bs + ks * 16), b1 = *(const bf16x8*)(Bs + 32 * LDT + ks * 16);
            acc[0][0] = MFMA(a0, b0, acc[0][0]); acc[0][1] = MFMA(a0, b1, acc[0][1]);
            acc[1][0] = MFMA(a1, b0, acc[1][0]); acc[1][1] = MFMA(a1, b1, acc[1][1]);
        }
    };
    const int KT = K >> 6;
    if (AF32) {
        f32x4 rf[4][2];
        auto gload = [&](int kt) {
#pragma unroll
            for (int j = 0; j < 4; ++j) {
                const int row = lr + 32 * j;
                const float* src = (const float*)Ap + (size_t)(m0 + row) * lda + kt * 64 + lc; rf[j][0] = *(const f32x4*)src; rf[j][1] = *(const f32x4*)(src + 4);
                rb[j] = *(const u32x4*)(Bt + (size_t)(n0 + row) * ldb + kt * 64 + lc);
            }
        };
        auto lstore = [&](int buf) {
            bf16_t* As = lds + buf * TILE_E; bf16_t* Bs = lds + (2 + buf) * TILE_E;
#pragma unroll
            for (int j = 0; j < 4; ++j) {
                const int row = lr + 32 * j;
                u32x4 v; v.x = pk2(rf[j][0][0], rf[j][0][1]); v.y = pk2(rf[j][0][2], rf[j][0][3]); v.z = pk2(rf[j][1][0], rf[j][1][1]); v.w = pk2(rf[j][1][2], rf[j][1][3]);
                *(u32x4*)(As + row * LDT + lc) = v;
                *(u32x4*)(Bs + row * LDT + lc) = rb[j];
            }
        };
        __syncthreads();
        gload(0); lstore(0); __syncthreads();
        for (int kt = 0; kt < KT; ++kt) {
            if (kt + 1 < KT) gload(kt + 1);
            __builtin_amdgcn_sched_barrier(0);
            compute(kt & 1);
            __builtin_amdgcn_sched_barrier(0);
            if (kt + 1 < KT) lstore((kt + 1) & 1);
            __syncthreads();
        }
        return;
    }
    u32x4 sa0[4], sb0[4], sa1[4], sb1[4];
    const bf16_t* Ag = (const bf16_t*)Ap + (size_t)(m0 + lr) * lda + lc;
    const bf16_t* Bg = Bt + (size_t)(n0 + lr) * ldb + lc;
    auto gl = [&](u32x4 (&xa)[4], u32x4 (&xb)[4], int kt) {
#pragma unroll
        for (int j = 0; j < 4; ++j) { xa[j] = *(const u32x4*)(Ag + (size_t)(32 * j) * lda + kt * 64); xb[j] = *(const u32x4*)(Bg + (size_t)(32 * j) * ldb + kt * 64); }
    };
    auto ls = [&](const u32x4 (&xa)[4], const u32x4 (&xb)[4], int buf) {
        bf16_t* As = lds + buf * TILE_E + lr * LDT + lc; bf16_t* Bs = lds + (2 + buf) * TILE_E + lr * LDT + lc;
#pragma unroll
        for (int j = 0; j < 4; ++j) { *(u32x4*)(As + 32 * j * LDT) = xa[j]; *(u32x4*)(Bs + 32 * j * LDT) = xb[j]; }
    };
    __syncthreads();
    gl(sa0, sb0, 0); gl(sa1, sb1, 1);
    ls(sa0, sb0, 0); __syncthreads();
    for (int kt = 0; kt < KT; kt += 2) {
        if (kt + 2 < KT) gl(sa0, sb0, kt + 2);
        __builtin_amdgcn_sched_barrier(0);
        compute(0);
        __builtin_amdgcn_sched_barrier(0);
        ls(sa1, sb1, 1);
        __syncthreads();
        if (kt + 3 < KT) gl(sa1, sb1, kt + 3);
        __builtin_amdgcn_sched_barrier(0);
        compute(1);
        __builtin_amdgcn_sched_barrier(0);
        if (kt + 2 < KT) ls(sa0, sb0, 0);
        __syncthreads();
    }
}

DI void gemm_kloop256(const bf16_t* __restrict__ A, int lda, const bf16_t* __restrict__ Bt, int ldb, int K, int m0, int n0, f32x16 (&acc)[4][2], bf16_t* lds) {
    const int tid = otid(), lane = tid & 63, w = __builtin_amdgcn_readfirstlane(tid >> 6), wr = w >> 1, wc = w & 1;
    const int lr = tid >> 3, lc = (tid & 7) * 8;
#pragma unroll
    for (int mi = 0; mi < 4; ++mi)
#pragma unroll
        for (int ni = 0; ni < 2; ++ni)
#pragma unroll
            for (int i = 0; i < 16; ++i) acc[mi][ni][i] = 0.f;
    u32x4 sa[8], sb[4];
    const bf16_t* Ag = A + (size_t)(m0 + lr) * lda + lc;
    const bf16_t* Bg = Bt + (size_t)(n0 + lr) * ldb + lc;
    auto gl = [&](int kt) {
#pragma unroll
        for (int j = 0; j < 8; ++j) sa[j] = *(const u32x4*)(Ag + (size_t)(32 * j) * lda + kt * 64);
#pragma unroll
        for (int j = 0; j < 4; ++j) sb[j] = *(const u32x4*)(Bg + (size_t)(32 * j) * ldb + kt * 64);
    };
    bf16_t* Aw = lds + lr * LDT + lc; bf16_t* Bw = lds + 256 * LDT + lr * LDT + lc;
    const bf16_t* Ar = lds + (wr * 64 + (lane & 31)) * LDT + (lane >> 5) * 8;
    const bf16_t* Br = lds + 256 * LDT + (wc * 64 + (lane & 31)) * LDT + (lane >> 5) * 8;
    const int KT = K >> 6;
    gl(0);
    for (int kt = 0; kt < KT; ++kt) {
        __syncthreads();
#pragma unroll
        for (int j = 0; j < 8; ++j) *(u32x4*)(Aw + 32 * j * LDT) = sa[j];
#pragma unroll
        for (int j = 0; j < 4; ++j) *(u32x4*)(Bw + 32 * j * LDT) = sb[j];
        __syncthreads();
        if (kt + 1 < KT) gl(kt + 1);
        __builtin_amdgcn_sched_barrier(0);
#pragma unroll
        for (int ks = 0; ks < 4; ++ks) {
            const bf16x8 b0 = *(const bf16x8*)(Br + ks * 16), b1 = *(const bf16x8*)(Br + 32 * LDT + ks * 16);
            const bf16x8 a0 = *(const bf16x8*)(Ar + ks * 16), a1 = *(const bf16x8*)(Ar + 32 * LDT + ks * 16);
            const bf16x8 a2 = *(const bf16x8*)(Ar + 128 * LDT + ks * 16), a3 = *(const bf16x8*)(Ar + 160 * LDT + ks * 16);
            acc[0][0] = MFMA(a0, b0, acc[0][0]); acc[0][1] = MFMA(a0, b1, acc[0][1]);
            acc[1][0] = MFMA(a1, b0, acc[1][0]); acc[1][1] = MFMA(a1, b1, acc[1][1]);
            acc[2][0] = MFMA(a2, b0, acc[2][0]); acc[2][1] = MFMA(a2, b1, acc[2][1]);
            acc[3][0] = MFMA(a3, b0, acc[3][0]); acc[3][1] = MFMA(a3, b1, acc[3][1]);
        }
        __builtin_amdgcn_sched_barrier(0);
    }
    __syncthreads();
}

DI void gemm_kloop_p(const float* __restrict__ Ap, const bf16_t* __restrict__ Bt, int m0, int n0, f32x16 (&acc)[2][2], bf16_t* lds) {
    const int tid = otid(), lane = tid & 63, w = __builtin_amdgcn_readfirstlane(tid >> 6), wr = w >> 1, wc = w & 1;
    const int lr = tid >> 3, lc = (tid & 7) * 8;
#pragma unroll
    for (int mi = 0; mi < 2; ++mi)
#pragma unroll
        for (int ni = 0; ni < 2; ++ni)
#pragma unroll
            for (int i = 0; i < 16; ++i) acc[mi][ni][i] = 0.f;
    f32x4 rf[4][2]; u32x4 rb[4];
    auto gload = [&](int kt) {
#pragma unroll
        for (int j = 0; j < 4; ++j) {
            const int row = lr + 32 * j;
            const float* src = Ap + (size_t)(m0 + row) * PLE + kt * 64 + lc; rf[j][0] = *(const f32x4*)src; rf[j][1] = *(const f32x4*)(src + 4);
            rb[j] = *(const u32x4*)(Bt + (size_t)(n0 + row) * PLE + kt * 64 + lc);
        }
    };
    bf16_t* As = lds + 2 * TILE_E; bf16_t* Bs = lds + 3 * TILE_E;
    gload(0);
    for (int kt = 0; kt < PLE / 64; ++kt) {
        __syncthreads();
#pragma unroll
        for (int j = 0; j < 4; ++j) {
            const int row = lr + 32 * j;
            u32x4 v; v.x = pk2(rf[j][0][0], rf[j][0][1]); v.y = pk2(rf[j][0][2], rf[j][0][3]); v.z = pk2(rf[j][1][0], rf[j][1][1]); v.w = pk2(rf[j][1][2], rf[j][1][3]);
            *(u32x4*)(As + row * LDT + lc) = v;
            *(u32x4*)(Bs + row * LDT + lc) = rb[j];
        }
        __syncthreads();
        if (kt + 1 < PLE / 64) gload(kt + 1);
        __builtin_amdgcn_sched_barrier(0);
        const bf16_t* Ar = As + (wr * 64 + (lane & 31)) * LDT + (lane >> 5) * 8;
        const bf16_t* Br = Bs + (wc * 64 + (lane & 31)) * LDT + (lane >> 5) * 8;
#pragma unroll
        for (int ks = 0; ks < 4; ++ks) {
            const bf16x8 a0 = *(const bf16x8*)(Ar + ks * 16), a1 = *(const bf16x8*)(Ar + 32 * LDT + ks * 16);
            const bf16x8 b0 = *(const bf16x8*)(Br + ks * 16), b1 = *(const bf16x8*)(Br + 32 * LDT + ks * 16);
            acc[0][0] = MFMA(a0, b0, acc[0][0]); acc[0][1] = MFMA(a0, b1, acc[0][1]);
            acc[1][0] = MFMA(a1, b0, acc[1][0]); acc[1][1] = MFMA(a1, b1, acc[1][1]);
        }
        __builtin_amdgcn_sched_barrier(0);
    }
}

DI float rstd_pre(const float* __restrict__ part, int m0) {
    const int tid = otid(), row = tid >> 1, half = tid & 1;
    const f32x4 a = *(const f32x4*)(part + (size_t)(m0 + row) * 8 + half * 4);
    float sm = (a[0] + a[1]) + (a[2] + a[3]);
    sm += __shfl_xor(sm, 1);
    return __builtin_amdgcn_rsqf(sm * (1.0f / DM) + 1e-6f);
}
DI void rstd_put(float v, float* rl) { rl[otid() >> 1] = v; __syncthreads(); }

DI void tile_rstd(const float* __restrict__ part, int m0, float* rl) {
    const int tid = otid(), row = tid >> 1, half = tid & 1;
    const f32x4 a = *(const f32x4*)(part + (size_t)(m0 + row) * 8 + half * 4);
    float sm = (a[0] + a[1]) + (a[2] + a[3]);
    sm += __shfl_xor(sm, 1);
    rl[row] = __builtin_amdgcn_rsqf(sm * (1.0f / DM) + 1e-6f);
    __syncthreads();
}

struct LC {
    const KP* P; unsigned char* ws; bf16_t *hb_cur, *hb_alt; int l; int pad_;
    DI unsigned char* R() const { return ws + OFF_R; }
    DI const bf16_t* wl() const { return (const bf16_t*)(ws + OFF_W) + (size_t)l * WL_TOT; }
    DI const bf16_t* w_in() const { return wl() + WL_IN; }
    DI const bf16_t* w_out() const { return wl() + WL_OUT; }
    DI const bf16_t* w_gu() const { return wl() + WL_GU; }
    DI const bf16_t* w_down() const { return wl() + WL_DOWN; }
    DI const bf16_t* w_pg() const { return wl() + WL_PG; }
    DI const bf16_t* w_pp() const { return wl() + WL_PP; }
    DI const float* wsf() const { return P->in[12] + (size_t)l * 4 * 128 * 128; }
    DI bf16_t* QA() const { return (bf16_t*)(R() + R_QA); }
    DI bf16_t* KA() const { return (bf16_t*)(R() + R_KA); }
    DI bf16_t* VA() const { return (bf16_t*)(R() + R_VA); }
    DI bf16_t* QB() const { return (bf16_t*)(R() + R_QB); }
    DI bf16_t* KB() const { return (bf16_t*)(R() + R_KB); }
    DI bf16_t* VB() const { return (bf16_t*)(R() + R_VB); }
    DI bf16_t* QC() const { return (bf16_t*)(R() + R_QC); }
    DI bf16_t* KC() const { return (bf16_t*)(R() + R_KC); }
    DI bf16_t* VC() const { return (bf16_t*)(R() + R_VC); }
    DI bf16_t* UD() const { return (bf16_t*)(R() + R_UD); }
    DI bf16_t* VD() const { return (bf16_t*)(R() + R_VD); }
    DI bf16_t* MIX() const { return (bf16_t*)(R() + R_MIX); }
    DI bf16_t* ACT() const { return (bf16_t*)(R() + R_ACT); }
    DI float* stash() const { return (float*)(R() + R_STASH); }
    DI float* rs_mix() const { return (float*)(ws + OFF_ROWSS); }
    DI float* rs_ffn() const { return (float*)(ws + OFF_ROWSS) + (size_t)8 * NTOK; }
    DI float* rs_ple() const { return (float*)(ws + OFF_ROWSS) + (size_t)16 * NTOK; }
    DI float* rs_next() const { return (float*)(ws + OFF_ROWSS); }
    DI const float* aqn() const { return P->in[4] + l * 64; }
    DI const float* akn() const { return P->in[5] + l * 64; }
    DI const float* bsub() const { return P->in[8] + l * 64; }
    DI const float* rpb() const { return P->in[9] + (size_t)l * 4 * 15 * 31; }
    DI const float* lng() const { return P->in[10] + l * 256; }
    DI const float* lnb() const { return P->in[11] + l * 256; }
    DI const float* bs() const { return P->in[13] + l * 512; }
    DI const float* p() const { return P->in[1] + (size_t)l * NTOK * PLE; }
    DI const float* lamp() const { return P->in[6] + l * 64; }
    DI const float* lamp2() const { return P->in[7] + l * 64; }
    DI unsigned* nmax() const { return (unsigned*)(ws + OFF_WS) + l * 32; }
    DI const float* res_src() const { return l == 0 ? P->in[0] : (const float*)P->out; }
    DI float* out() const { return P->out; }
    DI float lam_init() const { return 0.8f - 0.6f * __expf(-0.3f * (float)l); }
};

DI void store_vt(bf16_t* base, int d, int srow, float v0, float v1, float v2, float v3) {
    const int g = (srow >> 2) & 3, gp = ((g & 1) << 1) | (g >> 1);
    const int pos = (srow & ~15) + gp * 4;
    u32x2 pk; pk.x = pk2(v0, v1); pk.y = pk2(v2, v3);
    *(u32x2*)(base + (size_t)d * SEQ + pos) = pk;
}

DI float gelu_exact(float x) { return 0.5f * x * (1.0f + erff(x * 0.70710678118654752f)); }

DI void epi_proj(const f32x16 (&acc)[2][2], int m0, int n0, const LC& c, const float* rl, bf16_t* lds) {
    constexpr int TL = 136;
    const int tid = otid(), lane = tid & 63, w = __builtin_amdgcn_readfirstlane(tid >> 6), wr = w >> 1, wc = w & 1, ln = lane & 31, hh = lane >> 5;
    bf16_t* T = lds + 512;
    const int b = m0 / SEQ, sbase = m0 - b * SEQ;
    int mode, sec0, nh; bf16_t* base; float osc = 1.0f;
    if (n0 < 256)       { mode = 4; sec0 = 0;    nh = 4; base = c.QA(); osc = 0.125f * LOG2E; }
    else if (n0 < 384)  { mode = 4; sec0 = 256;  nh = 2; base = c.KA(); }
    else if (n0 < 512)  { mode = 2; sec0 = 384;  nh = 2; base = c.VA(); }
    else if (n0 < 768)  { mode = 1; sec0 = 512;  nh = 4; base = c.QB(); osc = 0.17677669529663687f * LOG2E; }
    else if (n0 < 1024) { mode = 1; sec0 = 768;  nh = 4; base = c.KB(); }
    else if (n0 < 1280) { mode = 2; sec0 = 1024; nh = 4; base = c.VB(); }
    else if (n0 < 1536) { mode = 0; sec0 = 1280; nh = 4; base = c.QC(); osc = 0.125f * LOG2E; }
    else if (n0 < 1792) { mode = 0; sec0 = 1536; nh = 4; base = c.KC(); }
    else if (n0 < 2048) { mode = 2; sec0 = 1792; nh = 4; base = c.VC(); }
    else if (n0 < 2304) { mode = 3; sec0 = 2048; nh = 1; base = c.UD(); }
    else                { mode = 3; sec0 = 2304; nh = 1; base = c.VD(); }
    const int lr0 = wr * 64, lc0 = wc * 64 + ln;
    if (mode == 4) {
        const bool isq = n0 < 256;
        const float* gn = isq ? c.aqn() : c.akn();
        const float g0 = gn[ln], g1 = gn[32 + ln];
        const float rinv = __builtin_amdgcn_exp2f(-(float)(ln & 15) * (13.287712379549449f / 16.0f)) * 0.15915494309189535f;
        float ssq[32];
#pragma unroll
        for (int mi = 0; mi < 2; ++mi)
#pragma unroll
            for (int i = 0; i < 16; ++i) {
                const float rstd = rl[lr0 + mi * 32 + crow(i, hh)];
                const float v0 = acc[mi][0][i] * rstd, v1 = acc[mi][1][i] * rstd;
                ssq[mi * 16 + i] = v0 * v0 + v1 * v1;
            }
        const float rnl = __builtin_amdgcn_rsqf(row_reduce32(ssq, ln) * (1.0f / 64.0f) + 1e-6f);
#pragma unroll
        for (int mi = 0; mi < 2; ++mi)
#pragma unroll
            for (int i = 0; i < 16; ++i) {
                const int lrow = lr0 + mi * 32 + crow(i, hh), s = sbase + lrow;
                const float rn = __shfl(rnl, (lane & 32) + mi * 16 + i) * rl[lrow];
                const float v0 = acc[mi][0][i] * rn * g0, v1 = acc[mi][1][i] * rn * g1;
                const float rev = (float)((ln < 16) ? (s >> 6) : (s & 63)) * rinv;
                const float fr = rev - rintf(rev);
                const float cs = __builtin_amdgcn_cosf(fr), sn = __builtin_amdgcn_sinf(fr);
                T[lrow * TL + lc0] = f2bf((v0 * cs - v1 * sn) * osc); T[lrow * TL + lc0 + 32] = f2bf((v1 * cs + v0 * sn) * osc);
            }
    } else if (mode == 2) {
#pragma unroll
        for (int mi = 0; mi < 2; ++mi)
#pragma unroll
            for (int q4 = 0; q4 < 4; ++q4) {
                const int lrow = lr0 + mi * 32 + q4 * 8 + hh * 4;
                const int g = (lrow >> 2) & 3, gp = ((g & 1) << 1) | (g >> 1), pos = (lrow & ~15) + gp * 4;
#pragma unroll
                for (int ni = 0; ni < 2; ++ni) {
                    u32x2 pk;
                    pk.x = pk2(acc[mi][ni][q4 * 4 + 0] * rl[lrow + 0], acc[mi][ni][q4 * 4 + 1] * rl[lrow + 1]);
                    pk.y = pk2(acc[mi][ni][q4 * 4 + 2] * rl[lrow + 2], acc[mi][ni][q4 * 4 + 3] * rl[lrow + 3]);
                    *(u32x2*)(T + (lc0 + ni * 32) * TL + pos) = pk;
                }
            }
    } else {
        float nq0[32], nq1[32];
#pragma unroll
        for (int mi = 0; mi < 2; ++mi)
#pragma unroll
            for (int i = 0; i < 16; ++i) {
                const int lrow = lr0 + mi * 32 + crow(i, hh);
                const float rstd = rl[lrow] * osc;
                float v0 = acc[mi][0][i] * rstd, v1 = acc[mi][1][i] * rstd;
                if (mode == 1) { nq0[mi * 16 + i] = v0 * v0; nq1[mi * 16 + i] = v1 * v1; }
                if (mode == 3) { v0 = gelu_exact(v0); v1 = gelu_exact(v1); }
                T[lrow * TL + lc0] = f2bf(v0); T[lrow * TL + lc0 + 32] = f2bf(v1);
            }
        if (mode == 1) {
            float mx0 = row_reduce32(nq0, ln), mx1 = row_reduce32(nq1, ln);
#pragma unroll
            for (int o = 32; o > 0; o >>= 1) { mx0 = fmaxf(mx0, __shfl_xor(mx0, o)); mx1 = fmaxf(mx1, __shfl_xor(mx1, o)); }
            const int hd = (n0 - sec0 + wc * 64) >> 6;
            unsigned* slot = c.nmax() + (((b * 4 + hd) * 2) * 2 + (sec0 == 768 ? 1 : 0));
            if (lane == 0) { atomicMax(slot, __float_as_uint(mx0)); atomicMax(slot + 2, __float_as_uint(mx1)); }
        }
    }
    __syncthreads();
#pragma unroll
    for (int j = 0; j < 8; ++j) {
        const int cidx = tid + 256 * j, row = cidx >> 4, cc = cidx & 15;
        const u32x4 v = *(const u32x4*)(T + row * TL + cc * 8);
        bf16_t* dst;
        if (mode == 2) {
            const int colh = n0 - sec0 + row;
            dst = base + ((size_t)(b * nh + (colh >> 6)) * 64 + (colh & 63)) * SEQ + sbase + cc * 8;
        } else {
            const int colh = n0 - sec0 + cc * 8, sq = sbase + row;
            if (mode == 3) dst = base + (size_t)(b * SEQ + sq) * 256 + colh;
            else if (mode == 1) dst = base + ((size_t)((b * 4 + (colh >> 6)) * 2 + ((colh & 63) >> 5)) * SEQ + sq) * 32 + (colh & 31);
            else dst = base + ((size_t)(b * nh + (colh >> 6)) * SEQ + sq) * 64 + (colh & 63);
        }
        *(u32x4*)dst = v;
    }
}

DI void epi_resid(const f32x16 (&add)[2][2], int m0, int n0, const bf16_t* hres, bf16_t* hb, float* __restrict__ part_next, bf16_t* lds) {
    constexpr int SLD = 132;
    const int tid = otid(), lane = tid & 63, w = __builtin_amdgcn_readfirstlane(tid >> 6), wr = w >> 1, wc = w & 1, ln = lane & 31, hh = lane >> 5;
    float* S = (float*)lds + 256;
#pragma unroll
    for (int mi = 0; mi < 2; ++mi)
#pragma unroll
        for (int ni = 0; ni < 2; ++ni)
#pragma unroll
            for (int i = 0; i < 16; ++i) S[(wr * 64 + mi * 32 + crow(i, hh)) * SLD + wc * 64 + ni * 32 + ln] = add[mi][ni][i];
    __syncthreads();
    const int cc = tid & 31, r0 = tid >> 5;
    const bf16_t* rp = hres + (size_t)(m0 + r0) * DM + n0 + cc * 4;
    u32x2 rv[16];
#pragma unroll
    for (int j = 0; j < 16; ++j) rv[j] = *(const u32x2*)(rp + (size_t)j * 8 * DM);
    __builtin_amdgcn_sched_barrier(0);
    float ssq[16];
#pragma unroll
    for (int j = 0; j < 16; ++j) {
        const int row = r0 + 8 * j;
        const f32x4 a = *(const f32x4*)(S + row * SLD + cc * 4);
        f32x4 h;
        h[0] = __uint_as_float(rv[j].x << 16) + a[0]; h[1] = __uint_as_float(rv[j].x & 0xffff0000u) + a[1];
        h[2] = __uint_as_float(rv[j].y << 16) + a[2]; h[3] = __uint_as_float(rv[j].y & 0xffff0000u) + a[3];
        u32x2 pk; pk.x = pk2(h[0], h[1]); pk.y = pk2(h[2], h[3]);
        *(u32x2*)(hb + (size_t)(m0 + row) * DM + n0 + cc * 4) = pk;
        ssq[j] = (h[0] * h[0] + h[1] * h[1]) + (h[2] * h[2] + h[3] * h[3]);
    }
#pragma unroll
    for (int j = 0; j < 8; ++j) { const bool up = (ln & 16) != 0; const float send = up ? ssq[j] : ssq[j + 8], keep = up ? ssq[j + 8] : ssq[j]; ssq[j] = keep + __shfl_xor(send, 16); }
#pragma unroll
    for (int j = 0; j < 4; ++j) { const bool up = (ln & 8) != 0; const float send = up ? ssq[j] : ssq[j + 4], keep = up ? ssq[j + 4] : ssq[j]; ssq[j] = keep + __shfl_xor(send, 8); }
#pragma unroll
    for (int j = 0; j < 2; ++j) { const bool up = (ln & 4) != 0; const float send = up ? ssq[j] : ssq[j + 2], keep = up ? ssq[j + 2] : ssq[j]; ssq[j] = keep + __shfl_xor(send, 4); }
    { const bool up = (ln & 2) != 0; const float send = up ? ssq[0] : ssq[1], keep = up ? ssq[1] : ssq[0]; ssq[0] = keep + __shfl_xor(send, 2); }
    const float tot = ssq[0] + __shfl_xor(ssq[0], 1);
    if ((ln & 1) == 0) part_next[(size_t)(m0 + r0 + 8 * (ln >> 1)) * 8 + (n0 >> 7)] = tot;
}

DI void epi_swiglu(const f32x16 (&acc)[2][2], int m0, int n0, const float* rl, bf16_t* __restrict__ act, bf16_t* lds) {
    constexpr int TL = 72;
    const int tid = otid(), lane = tid & 63, w = __builtin_amdgcn_readfirstlane(tid >> 6), wr = w >> 1, wc = w & 1, ln = lane & 31, hh = lane >> 5;
    bf16_t* T = lds + 512;
#pragma unroll
    for (int mi = 0; mi < 2; ++mi)
#pragma unroll
        for (int i = 0; i < 16; ++i) {
            const int row = wr * 64 + mi * 32 + crow(i, hh);
            const float rstd = rl[row];
            const float gv = acc[mi][0][i] * rstd, uv = acc[mi][1][i] * rstd;
            const float sg = gv * __builtin_amdgcn_rcpf(1.0f + __expf(-gv));
            T[row * TL + wc * 32 + ln] = f2bf(sg * uv);
        }
    __syncthreads();
#pragma unroll
    for (int j = 0; j < 4; ++j) {
        const int cidx = tid + 256 * j, row = cidx >> 3, cc = cidx & 7;
        *(u32x4*)(act + (size_t)(m0 + row) * FFN + (n0 >> 1) + cc * 8) = *(const u32x4*)(T + row * TL + cc * 8);
    }
}

DI void epi_gate_stage(const f32x16 (&g)[2][2], const float* rl, bf16_t* lds) {
    const int tid = otid(), lane = tid & 63, w = __builtin_amdgcn_readfirstlane(tid >> 6), wr = w >> 1, wc = w & 1, ln = lane & 31, hh = lane >> 5;
    bf16_t* T = lds + 512;
#pragma unroll
    for (int mi = 0; mi < 2; ++mi)
#pragma unroll
        for (int i = 0; i < 16; ++i) {
            const int lrow = wr * 64 + mi * 32 + crow(i, hh);
            const float rstd = rl[lrow];
            T[lrow * 136 + wc * 64 + ln] = f2bf(__builtin_amdgcn_rcpf(1.0f + __expf(-g[mi][0][i] * rstd)));
            T[lrow * 136 + wc * 64 + 32 + ln] = f2bf(__builtin_amdgcn_rcpf(1.0f + __expf(-g[mi][1][i] * rstd)));
        }
}
DI void epi_gate_apply(f32x16 (&acc)[2][2], const bf16_t* lds) {
    const int tid = otid(), lane = tid & 63, w = __builtin_amdgcn_readfirstlane(tid >> 6), wr = w >> 1, wc = w & 1, ln = lane & 31, hh = lane >> 5;
    const bf16_t* T = lds + 512;
#pragma unroll
    for (int mi = 0; mi < 2; ++mi)
#pragma unroll
        for (int i = 0; i < 16; ++i) {
            const int lrow = wr * 64 + mi * 32 + crow(i, hh);
            acc[mi][0][i] *= bf2f(T[lrow * 136 + wc * 64 + ln]);
            acc[mi][1][i] *= bf2f(T[lrow * 136 + wc * 64 + 32 + ln]);
        }
}

template <int DQK, int MODE>
DI void flash_block(const bf16_t* __restrict__ Qg, const bf16_t* __restrict__ Kg, const bf16_t* __restrict__ Vtg, int qbase, int kbeg, int kend,
                    float slope2, const float* __restrict__ rpbh, f32x16 (&O)[2][2], float (&lsum)[2], bf16_t* lds) {
    constexpr int KLD = DQK + 8, NKS = DQK / 16, KCH = DQK / 8, KJ = (64 * KCH) / 256;
    const int tid = otid(), lane = tid & 63, w = __builtin_amdgcn_readfirstlane(tid >> 6), ln = lane & 31, hh = lane >> 5;
    const int qw = qbase + w * 64;
    bf16x8 qf[2][NKS];
#pragma unroll
    for (int qi = 0; qi < 2; ++qi)
#pragma unroll
        for (int ks = 0; ks < NKS; ++ks) qf[qi][ks] = *(const bf16x8*)(Qg + (size_t)(qw + qi * 32 + ln) * DQK + ks * 16 + hh * 8);
    float m[2] = {-1e30f, -1e30f};
    lsum[0] = 0.f; lsum[1] = 0.f;
#pragma unroll
    for (int a = 0; a < 2; ++a)
#pragma unroll
        for (int b2 = 0; b2 < 2; ++b2)
#pragma unroll
            for (int i = 0; i < 16; ++i) O[a][b2][i] = 0.f;
    int r = 0, rs = 0;
    if (MODE == 2) { r = qw >> 6; rs = min(max(r - 4, 0), 248); }
    bf16_t* Ks = lds; bf16_t* Vs = lds + 2 * 64 * KLD;
    float* nat = (float*)(lds + 2 * 64 * KLD + 2 * 64 * 72);
    u32x4 rk[KJ], rv[2];
    auto gload = [&](int key0) {
#pragma unroll
        for (int j = 0; j < KJ; ++j) { const int cidx = tid + 256 * j, row = cidx / KCH, cc = cidx % KCH; rk[j] = *(const u32x4*)(Kg + (size_t)(key0 + row) * DQK + cc * 8); }
#pragma unroll
        for (int j = 0; j < 2; ++j) { const int cidx = tid + 256 * j, row = cidx >> 3, cc = cidx & 7; rv[j] = *(const u32x4*)(Vtg + (size_t)row * SEQ + key0 + cc * 8); }
    };
    auto lstore = [&](int buf) {
#pragma unroll
        for (int j = 0; j < KJ; ++j) { const int cidx = tid + 256 * j, row = cidx / KCH, cc = cidx % KCH; *(u32x4*)(Ks + buf * 64 * KLD + row * KLD + cc * 8) = rk[j]; }
#pragma unroll
        for (int j = 0; j < 2; ++j) { const int cidx = tid + 256 * j, row = cidx >> 3, cc = cidx & 7; *(u32x4*)(Vs + buf * 64 * 72 + row * 72 + cc * 8) = rv[j]; }
    };
    __syncthreads();
    if (MODE == 2) {
        for (int e = tid; e < 15 * 128; e += 256) { const int dc = (e & 127) - 48; nat[e] = (dc >= 0 && dc < 31) ? rpbh[(e >> 7) * 31 + dc] * LOG2E : 0.f; }
    }
    gload(kbeg); lstore(0); __syncthreads();
    const int nt = (kend - kbeg) >> 6;
    for (int it = 0; it < nt; ++it) {
        const int key0 = kbeg + it * 64;
        if (it + 1 < nt) gload(key0 + 64);
        __builtin_amdgcn_sched_barrier(0);
        bool active = true;
        if (MODE == 2) { const int kr = key0 >> 6; active = (kr >= rs) && (kr < rs + 8); }
        if (active) {
            const int buf = it & 1;
            const bf16_t* kp = Ks + buf * 64 * KLD + ln * KLD + hh * 8;
            const bf16_t* vp = Vs + buf * 64 * 72 + ln * 72 + hh * 8;
#pragma unroll
            for (int kt = 0; kt < 2; ++kt) {
                f32x16 s[2];
#pragma unroll
                for (int b2 = 0; b2 < 2; ++b2)
#pragma unroll
                    for (int i = 0; i < 16; ++i) s[b2][i] = 0.f;
#pragma unroll
                for (int ks = 0; ks < NKS; ++ks) {
                    const bf16x8 kf = *(const bf16x8*)(kp + kt * 32 * KLD + ks * 16);
                    s[0] = MFMA(kf, qf[0][ks], s[0]);
                    s[1] = MFMA(kf, qf[1][ks], s[1]);
                }
                if (MODE == 1) {
#pragma unroll
                    for (int qi = 0; qi < 2; ++qi) {
                        const float base = (float)(qw + qi * 32 + ln - (key0 + kt * 32 + hh * 4));
#pragma unroll
                        for (int i = 0; i < 16; ++i) s[qi][i] -= slope2 * fabsf(base - (float)((i & 3) + 8 * (i >> 2)));
                    }
                }
                if (MODE == 2) {
                    const int dr = (key0 >> 6) - r + 7;
#pragma unroll
                    for (int qi = 0; qi < 2; ++qi) {
                        const int qc = qi * 32 + ln, cs = min(max(qc - 8, 0), 48);
                        const float* tb = nat + dr * 128 + (kt * 32 + 4 * hh - qc + 15 + 48);
#pragma unroll
                        for (int i = 0; i < 16; ++i) {
                            const int kc = kt * 32 + crow(i, hh);
                            const bool valid = (kc >= cs) && (kc < cs + 16);
                            const float bias = tb[(i & 3) + 8 * (i >> 2)];
                            s[qi][i] = valid ? (s[qi][i] + bias) : -1e30f;
                        }
                    }
                }
                float alpha[2]; bool chg = false;
#pragma unroll
                for (int qi = 0; qi < 2; ++qi) {
                    float mx = s[qi][0];
#pragma unroll
                    for (int i = 1; i < 16; ++i) mx = fmaxf(mx, s[qi][i]);
                    mx = fmaxf(mx, __shfl_xor(mx, 32));
                    const float mnew = fmaxf(m[qi], mx);
                    alpha[qi] = __builtin_amdgcn_exp2f(m[qi] - mnew);
                    chg = chg || (mnew > m[qi]);
                    m[qi] = mnew;
                }
                if (__any(chg)) {
#pragma unroll
                    for (int qi = 0; qi < 2; ++qi) {
                        lsum[qi] *= alpha[qi];
#pragma unroll
                        for (int dt = 0; dt < 2; ++dt)
#pragma unroll
                            for (int i = 0; i < 16; ++i) O[dt][qi][i] *= alpha[qi];
                    }
                }
                bf16x8 pf[2][2];
#pragma unroll
                for (int qi = 0; qi < 2; ++qi) {
                    float ls = 0.f;
#pragma unroll
                    for (int i = 0; i < 16; ++i) { const float p = __builtin_amdgcn_exp2f(s[qi][i] - m[qi]); s[qi][i] = p; ls += p; }
#pragma unroll
                    for (int s2 = 0; s2 < 2; ++s2) {
                        u32x4 pk;
                        pk.x = pk2(s[qi][8 * s2 + 0], s[qi][8 * s2 + 1]); pk.y = pk2(s[qi][8 * s2 + 2], s[qi][8 * s2 + 3]);
                        pk.z = pk2(s[qi][8 * s2 + 4], s[qi][8 * s2 + 5]); pk.w = pk2(s[qi][8 * s2 + 6], s[qi][8 * s2 + 7]);
                        pf[s2][qi] = __builtin_bit_cast(bf16x8, pk);
                    }
                    lsum[qi] += ls;
                }
#pragma unroll
                for (int s2 = 0; s2 < 2; ++s2)
#pragma unroll
                    for (int dt = 0; dt < 2; ++dt) {
                        const bf16x8 vf = *(const bf16x8*)(vp + dt * 32 * 72 + kt * 32 + s2 * 16);
                        O[dt][0] = MFMA(vf, pf[s2][0], O[dt][0]);
                        O[dt][1] = MFMA(vf, pf[s2][1], O[dt][1]);
                    }
            }
        }
        __builtin_amdgcn_sched_barrier(0);
        if (it + 1 < nt) lstore((it + 1) & 1);
        __syncthreads();
    }
}

template <int DQK, bool ALIBI, int NQI>
DI void flash_fixed(const bf16_t* __restrict__ Qg, const bf16_t* __restrict__ Kg, const bf16_t* __restrict__ Vtg, int qbase, int kbeg, int kend,
                    float mfix_, float slope2_, f32x16 (&O)[2][NQI], float (&lsum)[NQI], bf16_t* lds, bool init = true, int kbeg2 = 0, int kend2 = 0) {
    constexpr int KLD = DQK + 8, NKS = DQK / 16, KCH = DQK / 8, KJ = (64 * KCH) / 256;
    const float mfix = opq(mfix_), slope2 = opq(slope2_);
    const int tid = otid(), lane = tid & 63, w = __builtin_amdgcn_readfirstlane(tid >> 6), ln = lane & 31, hh = lane >> 5;
    const int qw = qbase + w * (32 * NQI);
    bf16x8 qf[NQI][NKS];
#pragma unroll
    for (int qi = 0; qi < NQI; ++qi)
#pragma unroll
        for (int ks = 0; ks < NKS; ++ks) qf[qi][ks] = *(const bf16x8*)(Qg + (size_t)(qw + qi * 32 + ln) * DQK + ks * 16 + hh * 8);
    f32x16 cinit;
#pragma unroll
    for (int i = 0; i < 16; ++i) cinit[i] = -mfix;
    if (init) {
#pragma unroll
    for (int qi = 0; qi < NQI; ++qi) lsum[qi] = 0.f;
#pragma unroll
    for (int a = 0; a < 2; ++a)
#pragma unroll
        for (int b2 = 0; b2 < NQI; ++b2)
#pragma unroll
            for (int i = 0; i < 16; ++i) O[a][b2][i] = 0.f;
    }
    bf16_t* Ks = lds; bf16_t* Vs = lds + 2 * 64 * KLD;
    u32x4 rk[KJ], rv[2];
    auto gload = [&](int key0) {
#pragma unroll
        for (int j = 0; j < KJ; ++j) { const int cidx = tid + 256 * j, row = cidx / KCH, cc = cidx % KCH; rk[j] = *(const u32x4*)(Kg + (size_t)(key0 + row) * DQK + cc * 8); }
#pragma unroll
        for (int j = 0; j < 2; ++j) { const int cidx = tid + 256 * j, row = cidx >> 3, cc = cidx & 7; rv[j] = *(const u32x4*)(Vtg + (size_t)row * SEQ + key0 + cc * 8); }
    };
    auto lstore = [&](int buf) {
#pragma unroll
        for (int j = 0; j < KJ; ++j) { const int cidx = tid + 256 * j, row = cidx / KCH, cc = cidx % KCH; *(u32x4*)(Ks + buf * 64 * KLD + row * KLD + cc * 8) = rk[j]; }
#pragma unroll
        for (int j = 0; j < 2; ++j) { const int cidx = tid + 256 * j, row = cidx >> 3, cc = cidx & 7; *(u32x4*)(Vs + buf * 64 * 72 + row * 72 + cc * 8) = rv[j]; }
    };
    __syncthreads();
    const int n1 = (kend - kbeg) >> 6, nt = n1 + ((kend2 - kbeg2) >> 6);
    if (nt == 0) return;
    gload(n1 > 0 ? kbeg : kbeg2); lstore(0); __syncthreads();
    for (int it = 0; it < nt; ++it) {
        const int key0 = it < n1 ? kbeg + it * 64 : kbeg2 + (it - n1) * 64;
        if (it + 1 < nt) gload(it + 1 < n1 ? kbeg + (it + 1) * 64 : kbeg2 + (it + 1 - n1) * 64);
        __builtin_amdgcn_sched_barrier(0);
        const int buf = it & 1;
        const bf16_t* kp = Ks + buf * 64 * KLD + ln * KLD + hh * 8;
        const bf16_t* vp = Vs + buf * 64 * 72 + ln * 72 + hh * 8;
#pragma unroll
        for (int kt = 0; kt < 2; ++kt) {
            f32x16 s[NQI];
            const int kb = key0 + kt * 32;
            int side = 0;
            if (ALIBI) {
                side = (kb + 31 < qw) ? 1 : ((kb > qw + 32 * NQI - 1) ? -1 : 0);
                const float fs = (float)side * slope2;
#pragma unroll
                for (int qi = 0; qi < NQI; ++qi) {
                    const float c0 = -mfix - fs * (float)(qw + qi * 32 + ln - (kb + 4 * hh));
#pragma unroll
                    for (int i = 0; i < 16; ++i) s[qi][i] = fmaf(fs, (float)((i & 3) + 8 * (i >> 2)), c0);
                }
            }
#pragma unroll
            for (int ks = 0; ks < NKS; ++ks) {
                const bf16x8 kf = *(const bf16x8*)(kp + kt * 32 * KLD + ks * 16);
#pragma unroll
                for (int qi = 0; qi < NQI; ++qi) s[qi] = (!ALIBI && ks == 0) ? MFMA(kf, qf[qi][0], cinit) : MFMA(kf, qf[qi][ks], s[qi]);
            }
            if (ALIBI) {
                if (side == 0) {
#pragma unroll
                    for (int qi = 0; qi < NQI; ++qi) {
                        const float base = (float)(qw + qi * 32 + ln - (kb + 4 * hh));
#pragma unroll
                        for (int i = 0; i < 16; ++i) s[qi][i] -= slope2 * fabsf(base - (float)((i & 3) + 8 * (i >> 2)));
                    }
                }
            }
            bf16x8 pf[2][NQI];
#pragma unroll
            for (int qi = 0; qi < NQI; ++qi) {
                float ls = 0.f;
#pragma unroll
                for (int i = 0; i < 16; ++i) { const float p = __builtin_amdgcn_exp2f(s[qi][i]); s[qi][i] = p; ls += p; }
#pragma unroll
                for (int s2 = 0; s2 < 2; ++s2) {
                    u32x4 pk;
                    pk.x = pk2(s[qi][8 * s2 + 0], s[qi][8 * s2 + 1]); pk.y = pk2(s[qi][8 * s2 + 2], s[qi][8 * s2 + 3]);
                    pk.z = pk2(s[qi][8 * s2 + 4], s[qi][8 * s2 + 5]); pk.w = pk2(s[qi][8 * s2 + 6], s[qi][8 * s2 + 7]);
                    pf[s2][qi] = __builtin_bit_cast(bf16x8, pk);
                }
                lsum[qi] += ls;
            }
#pragma unroll
            for (int s2 = 0; s2 < 2; ++s2)
#pragma unroll
                for (int dt = 0; dt < 2; ++dt) {
                    const bf16x8 vf = *(const bf16x8*)(vp + dt * 32 * 72 + kt * 32 + s2 * 16);
#pragma unroll
                    for (int qi = 0; qi < NQI; ++qi) O[dt][qi] = MFMA(vf, pf[s2][qi], O[dt][qi]);
                }
        }
        __builtin_amdgcn_sched_barrier(0);
        if (it + 1 < nt) lstore((it + 1) & 1);
        __syncthreads();
    }
}

DI void flash_fixedA(const bf16_t* __restrict__ Qg, const bf16_t* __restrict__ Kg, const bf16_t* __restrict__ Vtg, int qbase, int kbeg, int kend,
                     float mfix_, f32x16 (&O)[2][2], float (&lsum)[2], bf16_t* lds) {
    constexpr int KLD = 72;
    const float mfix = opq(mfix_);
    const int tid = otid(), lane = tid & 63, w = __builtin_amdgcn_readfirstlane(tid >> 6), ln = lane & 31, hh = lane >> 5;
    lsum[0] = 0.f; lsum[1] = 0.f;
#pragma unroll
    for (int a = 0; a < 2; ++a)
#pragma unroll
        for (int b2 = 0; b2 < 2; ++b2)
#pragma unroll
            for (int i = 0; i < 16; ++i) O[a][b2][i] = 0.f;
    bf16_t* Ks = lds; bf16_t* Vs = lds + 2 * 64 * KLD; bf16_t* Qs = lds + 4 * 64 * KLD;
    u32x4 rk[2], rv[2];
    auto gload = [&](int key0) {
#pragma unroll
        for (int j = 0; j < 2; ++j) { const int cidx = tid + 256 * j, row = cidx >> 3, cc = cidx & 7; rk[j] = *(const u32x4*)(Kg + (size_t)(key0 + row) * 64 + cc * 8); rv[j] = *(const u32x4*)(Vtg + (size_t)row * SEQ + key0 + cc * 8); }
    };
    auto lstore = [&](int buf) {
#pragma unroll
        for (int j = 0; j < 2; ++j) { const int cidx = tid + 256 * j, row = cidx >> 3, cc = cidx & 7; *(u32x4*)(Ks + buf * 64 * KLD + row * KLD + cc * 8) = rk[j]; *(u32x4*)(Vs + buf * 64 * 72 + row * 72 + cc * 8) = rv[j]; }
    };
    __syncthreads();
#pragma unroll
    for (int j = 0; j < 8; ++j) { const int cidx = tid + 256 * j, row = cidx >> 3, cc = cidx & 7; *(u32x4*)(Qs + row * KLD + cc * 8) = *(const u32x4*)(Qg + (size_t)(qbase + row) * 64 + cc * 8); }
    gload(kbeg); lstore(0); __syncthreads();
    const bf16_t* qp = Qs + (w * 64 + ln) * KLD + hh * 8;
    const int nt = (kend - kbeg) >> 6;
    for (int it = 0; it < nt; ++it) {
        const int key0 = kbeg + it * 64;
        if (it + 1 < nt) gload(key0 + 64);
        __builtin_amdgcn_sched_barrier(0);
        const int buf = it & 1;
        const bf16_t* kp = Ks + buf * 64 * KLD + ln * KLD + hh * 8;
        const bf16_t* vp = Vs + buf * 64 * 72 + ln * 72 + hh * 8;
        f32x16 s[2][2];
#pragma unroll
        for (int kt = 0; kt < 2; ++kt)
#pragma unroll
            for (int qi = 0; qi < 2; ++qi)
#pragma unroll
                for (int i = 0; i < 16; ++i) s[kt][qi][i] = -mfix;
#pragma unroll
        for (int ks = 0; ks < 4; ++ks) {
            const bf16x8 q0 = *(const bf16x8*)(qp + ks * 16), q1 = *(const bf16x8*)(qp + 32 * KLD + ks * 16);
            const bf16x8 k0 = *(const bf16x8*)(kp + ks * 16), k1 = *(const bf16x8*)(kp + 32 * KLD + ks * 16);
            s[0][0] = MFMA(k0, q0, s[0][0]); s[0][1] = MFMA(k0, q1, s[0][1]);
            s[1][0] = MFMA(k1, q0, s[1][0]); s[1][1] = MFMA(k1, q1, s[1][1]);
        }
#pragma unroll
        for (int kt = 0; kt < 2; ++kt) {
            bf16x8 pf[2][2];
#pragma unroll
            for (int qi = 0; qi < 2; ++qi) {
                float ls = 0.f;
#pragma unroll
                for (int i = 0; i < 16; ++i) { const float p = __builtin_amdgcn_exp2f(s[kt][qi][i]); s[kt][qi][i] = p; ls += p; }
#pragma unroll
                for (int s2 = 0; s2 < 2; ++s2) {
                    u32x4 pk;
                    pk.x = pk2(s[kt][qi][8 * s2 + 0], s[kt][qi][8 * s2 + 1]); pk.y = pk2(s[kt][qi][8 * s2 + 2], s[kt][qi][8 * s2 + 3]);
                    pk.z = pk2(s[kt][qi][8 * s2 + 4], s[kt][qi][8 * s2 + 5]); pk.w = pk2(s[kt][qi][8 * s2 + 6], s[kt][qi][8 * s2 + 7]);
                    pf[s2][qi] = __builtin_bit_cast(bf16x8, pk);
                }
                lsum[qi] += ls;
            }
#pragma unroll
            for (int s2 = 0; s2 < 2; ++s2)
#pragma unroll
                for (int dt = 0; dt < 2; ++dt) {
                    const bf16x8 vf = *(const bf16x8*)(vp + dt * 32 * 72 + kt * 32 + s2 * 16);
                    O[dt][0] = MFMA(vf, pf[s2][0], O[dt][0]);
                    O[dt][1] = MFMA(vf, pf[s2][1], O[dt][1]);
                }
        }
        __builtin_amdgcn_sched_group_barrier(0x008, 16, 0);
        __builtin_amdgcn_sched_group_barrier(0x400, 32, 0);
        __builtin_amdgcn_sched_group_barrier(0x008, 1, 0);
        __builtin_amdgcn_sched_group_barrier(0x400, 4, 0);
        __builtin_amdgcn_sched_group_barrier(0x008, 1, 0);
        __builtin_amdgcn_sched_group_barrier(0x400, 4, 0);
        __builtin_amdgcn_sched_group_barrier(0x008, 1, 0);
        __builtin_amdgcn_sched_group_barrier(0x400, 4, 0);
        __builtin_amdgcn_sched_group_barrier(0x008, 1, 0);
        __builtin_amdgcn_sched_group_barrier(0x400, 4, 0);
        __builtin_amdgcn_sched_group_barrier(0x008, 1, 0);
        __builtin_amdgcn_sched_group_barrier(0x400, 4, 0);
        __builtin_amdgcn_sched_group_barrier(0x008, 1, 0);
        __builtin_amdgcn_sched_group_barrier(0x400, 4, 0);
        __builtin_amdgcn_sched_group_barrier(0x008, 1, 0);
        __builtin_amdgcn_sched_group_barrier(0x400, 4, 0);
        __builtin_amdgcn_sched_group_barrier(0x008, 1, 0);
        __builtin_amdgcn_sched_group_barrier(0x400, 4, 0);
        __builtin_amdgcn_sched_group_barrier(0x008, 8, 0);
        __builtin_amdgcn_sched_barrier(0);
        if (it + 1 < nt) lstore((it + 1) & 1);
        __syncthreads();
    }
}

DI void store_o(const f32x16 (&O)[2][2], const float (&lsum)[2], bf16_t* __restrict__ mixrow0  , int qw) {
    const int lane = otid() & 63, ln = lane & 31, hh = lane >> 5;
#pragma unroll
    for (int qi = 0; qi < 2; ++qi) {
        const float lt = lsum[qi] + __shfl_xor(lsum[qi], 32);
        const float inv = __builtin_amdgcn_rcpf(lt);
        bf16_t* o = mixrow0 + (size_t)(qw + qi * 32 + ln) * DM;
#pragma unroll
        for (int dt = 0; dt < 2; ++dt)
#pragma unroll
            for (int q4 = 0; q4 < 4; ++q4) {
                u32x2 pk; pk.x = pk2(O[dt][qi][q4 * 4 + 0] * inv, O[dt][qi][q4 * 4 + 1] * inv); pk.y = pk2(O[dt][qi][q4 * 4 + 2] * inv, O[dt][qi][q4 * 4 + 3] * inv);
                *(u32x2*)(o + dt * 32 + q4 * 8 + hh * 4) = pk;
            }
    }
}

DI void attn_item_A(int item, const LC& c, bf16_t* lds) {
    const int bh = item >> 6, qblk = item & 63, b = bh >> 2, h = bh & 3, kvh = h >> 1;
    const int lane = otid() & 63;
    float gq = fabsf(c.aqn()[lane]), gk = fabsf(c.akn()[lane]);
#pragma unroll
    for (int o = 32; o > 0; o >>= 1) { gq = fmaxf(gq, __shfl_xor(gq, o)); gk = fmaxf(gk, __shfl_xor(gk, o)); }
    const float smax = 8.0f * gq * gk * LOG2E * 1.01f;
    f32x16 O[2][2]; float ls[2];
    const bf16_t* Q = c.QA() + (size_t)bh * SEQ * 64; const bf16_t* K = c.KA() + (size_t)(b * 2 + kvh) * SEQ * 64; const bf16_t* V = c.VA() + (size_t)(b * 2 + kvh) * 64 * SEQ;
    flash_fixedA(Q, K, V, qblk * 256, 0, SEQ, fminf(smax, 64.0f), O, ls, lds);
    store_o(O, ls, c.MIX() + (size_t)b * SEQ * DM + h * 64, qblk * 256 + __builtin_amdgcn_readfirstlane(otid() >> 6) * 64);
}

DI void attn_item_C(int item, const LC& c, bf16_t* lds) {
    const int bh = item >> 6, rq = item & 63, b = bh >> 2, h = bh & 3;
    const int r0 = rq * 4, kb = min(max(r0 - 4, 0), 248), ke = min(max(r0 + 3 - 4, 0), 248) + 8;
    f32x16 O[2][2]; float ls[2];
    flash_block<64, 2>(c.QC() + (size_t)bh * SEQ * 64, c.KC() + (size_t)bh * SEQ * 64, c.VC() + (size_t)bh * 64 * SEQ, r0 * 64, kb * 64, ke * 64, 0.f, c.rpb() + h * 15 * 31, O, ls, lds);
    store_o(O, ls, c.MIX() + (size_t)b * SEQ * DM + 512 + h * 64, r0 * 64 + __builtin_amdgcn_readfirstlane(otid() >> 6) * 64);
}

DI void attn_item_B(int item, const LC& c, bf16_t* lds) {
    const int bh = item >> 7, qblk = item & 127, b = bh >> 2, h = bh & 3;
    const int tid = otid(), lane = tid & 63, ln = lane & 31, hh = lane >> 5;
    const float slope2 = __builtin_amdgcn_exp2f(-2.0f * (float)(h + 1)) * LOG2E;
    float* st = c.stash() + ((size_t)blockIdx.x * 256 + tid) * 64;
    const bf16_t* Vt = c.VB() + (size_t)bh * 64 * SEQ;
    const int q0 = qblk * 128;
    const int qw = q0 + __builtin_amdgcn_readfirstlane(tid >> 6) * 32;
    const float osc = 1.0f - c.lam_init();
    float lam;
    {
        const float* lq = c.lamp(); const float* lk = c.lamp2();
        float pr = lq[lane] * lk[lane];
        pr = half_sum(pr);
        const float e0 = __shfl(pr, 0), e1 = __shfl(pr, 32);
        lam = __expf(e0) - __expf(e1) + c.lam_init();
    }
#pragma unroll 1
    for (int mp = 0; mp < 2; ++mp) {
        f32x16 O[2][1]; float ls[1];
        const bf16_t* Q = c.QB() + (size_t)(bh * 2 + mp) * SEQ * 32; const bf16_t* K = c.KB() + (size_t)(bh * 2 + mp) * SEQ * 32;
        const float nq2 = __uint_as_float(__hip_atomic_load(c.nmax() + (bh * 2 + mp) * 2, __ATOMIC_RELAXED, __HIP_MEMORY_SCOPE_AGENT));
        const float nk2 = __uint_as_float(__hip_atomic_load(c.nmax() + (bh * 2 + mp) * 2 + 1, __ATOMIC_RELAXED, __HIP_MEMORY_SCOPE_AGENT));
        const float smax = __builtin_amdgcn_sqrtf(nq2 * nk2) * 1.01f;
        const float mfix = fminf(smax, 64.0f);
        const int nw = min(512, max(64, ((int)(24.0f * __builtin_amdgcn_rcpf(slope2)) + 63) & ~63));
        const int nlo = max(0, (q0 - nw) & ~63), nhi = min(SEQ, (q0 + 127 + nw + 64) & ~63);
        flash_fixed<32, true, 1>(Q, K, Vt, q0, nlo, nhi, mfix, slope2, O, ls, lds, true);
        float lm = ls[0] + __shfl_xor(ls[0], 32);
#pragma unroll
        for (int o = 16; o > 0; o >>= 1) lm = fminf(lm, __shfl_xor(lm, o));
        float* red = (float*)lds + 18000;
        __syncthreads();
        if (lane == 0) red[__builtin_amdgcn_readfirstlane(tid >> 6)] = lm;
        __syncthreads();
        const float lmin = fminf(fminf(red[0], red[1]), fminf(red[2], red[3]));
        const float need = 26.0f + __builtin_amdgcn_logf(2.0f * __builtin_amdgcn_rcpf(1.0f - __builtin_amdgcn_exp2f(-slope2))) * 1.01f + 0.5f + (smax - mfix) - __builtin_amdgcn_logf(lmin);
        const int dwin = (int)fminf(fmaxf(need, 0.f) * __builtin_amdgcn_rcpf(slope2) * 1.001f + 2.0f, 32768.0f);
        const int kb0 = max(0, (q0 - dwin) & ~63), ke0 = min(SEQ, (q0 + 127 + dwin + 64) & ~63);
        if (kb0 < nlo || ke0 > nhi) flash_fixed<32, true, 1>(Q, K, Vt, q0, kb0, max(kb0, nlo), mfix, slope2, O, ls, lds, false, nhi, max(nhi, ke0));
        if (mp == 0) {
            const float inv = __builtin_amdgcn_rcpf(ls[0] + __shfl_xor(ls[0], 32));
#pragma unroll
            for (int dt = 0; dt < 2; ++dt)
#pragma unroll
                for (int q4 = 0; q4 < 4; ++q4) {
                    f32x4 v = {O[dt][0][q4 * 4] * inv, O[dt][0][q4 * 4 + 1] * inv, O[dt][0][q4 * 4 + 2] * inv, O[dt][0][q4 * 4 + 3] * inv};
                    *(f32x4*)(st + dt * 16 + q4 * 4) = v;
                }
        } else {
            const float inv = lam * __builtin_amdgcn_rcpf(ls[0] + __shfl_xor(ls[0], 32));
            float ss = 0.f;
#pragma unroll
            for (int dt = 0; dt < 2; ++dt)
#pragma unroll
                for (int q4 = 0; q4 < 4; ++q4) {
                    const f32x4 v = *(const f32x4*)(st + dt * 16 + q4 * 4);
#pragma unroll
                    for (int j = 0; j < 4; ++j) { const float a = v[j] - O[dt][0][q4 * 4 + j] * inv; O[dt][0][q4 * 4 + j] = a; ss += a * a; }
                }
            ss += __shfl_xor(ss, 32);
            const float rn = __builtin_amdgcn_rsqf(ss * (1.0f / 64.0f) + 1e-6f) * osc;
            bf16_t* o = c.MIX() + ((size_t)b * SEQ + qw + ln) * DM + 256 + h * 64;
#pragma unroll
            for (int dt = 0; dt < 2; ++dt)
#pragma unroll
                for (int q4 = 0; q4 < 4; ++q4) {
                    const int d = dt * 32 + q4 * 8 + hh * 4;
                    const f32x4 g = *(const f32x4*)(c.bsub() + d);
                    u32x2 pk; pk.x = pk2(O[dt][0][q4 * 4 + 0] * rn * g[0], O[dt][0][q4 * 4 + 1] * rn * g[1]); pk.y = pk2(O[dt][0][q4 * 4 + 2] * rn * g[2], O[dt][0][q4 * 4 + 3] * rn * g[3]);
                    *(u32x2*)(o + d) = pk;
                }
        }
    }
}

DI void sgu_item(int item, const LC& c, bf16_t* lds) {
    constexpr int TLD = 136;
    const int tid = otid(), lane = tid & 63, w = __builtin_amdgcn_readfirstlane(tid >> 6), ln = lane & 31, hh = lane >> 5;
    const size_t t0 = (size_t)item * 128;
    __syncthreads();
    {
        const int tok = tid >> 1, half = tid & 1;
        const bf16_t* src = c.VD() + (t0 + tok) * 256 + half * 128;
        float sum = 0.f, sq = 0.f;
#pragma unroll 4
        for (int j = 0; j < 16; ++j) {
            const u32x4 raw = *(const u32x4*)(src + j * 8);
#pragma unroll
            for (int e = 0; e < 4; ++e) { const float a = __uint_as_float(raw[e] << 16), b2 = __uint_as_float(raw[e] & 0xffff0000u); sum += a + b2; sq += a * a + b2 * b2; }
        }
        sum += __shfl_xor(sum, 1); sq += __shfl_xor(sq, 1);
        const float mean = sum * (1.0f / 256.0f);
        const float rstd = __builtin_amdgcn_rsqf(fmaxf(sq * (1.0f / 256.0f) - mean * mean, 0.f) + 1e-5f);
#pragma unroll 2
        for (int j = 0; j < 16; ++j) {
            const u32x4 raw = *(const u32x4*)(src + j * 8);
#pragma unroll
            for (int e = 0; e < 4; ++e) {
                const int col = half * 128 + j * 8 + e * 2;
                const float a = (__uint_as_float(raw[e] << 16) - mean) * rstd * c.lng()[col] + c.lnb()[col];
                const float b2 = (__uint_as_float(raw[e] & 0xffff0000u) - mean) * rstd * c.lng()[col + 1] + c.lnb()[col + 1];
                lds[col * TLD + tok] = f2bf(a); lds[(col + 1) * TLD + tok] = f2bf(b2);
            }
        }
    }
    __syncthreads();
    const int g = w;
    const float* Wg = c.wsf() + (size_t)g * 128 * 128;
#pragma unroll 1
    for (int mh = 0; mh < 2; ++mh) {
        f32x16 acc[2][2];
#pragma unroll
        for (int a = 0; a < 2; ++a)
#pragma unroll
            for (int b2 = 0; b2 < 2; ++b2)
#pragma unroll
                for (int i = 0; i < 16; ++i) acc[a][b2][i] = 0.f;
#pragma unroll
        for (int ks = 0; ks < 8; ++ks) {
            bf16x8 a0, a1;
            {
                const float* p0 = Wg + (size_t)(mh * 64 + ln) * 128 + ks * 16 + hh * 8; const float* p1 = p0 + 32 * 128;
                const f32x4 x0 = *(const f32x4*)p0, x1 = *(const f32x4*)(p0 + 4), y0 = *(const f32x4*)p1, y1 = *(const f32x4*)(p1 + 4);
                u32x4 pa, pb;
                pa.x = pk2(x0[0], x0[1]); pa.y = pk2(x0[2], x0[3]); pa.z = pk2(x1[0], x1[1]); pa.w = pk2(x1[2], x1[3]);
                pb.x = pk2(y0[0], y0[1]); pb.y = pk2(y0[2], y0[3]); pb.z = pk2(y1[0], y1[1]); pb.w = pk2(y1[2], y1[3]);
                a0 = __builtin_bit_cast(bf16x8, pa); a1 = __builtin_bit_cast(bf16x8, pb);
            }
            const bf16x8 b0 = *(const bf16x8*)(lds + (g * 64 + ln) * TLD + ks * 16 + hh * 8);
            const bf16x8 b1 = *(const bf16x8*)(lds + (g * 64 + 32 + ln) * TLD + ks * 16 + hh * 8);
            acc[0][0] = MFMA(a0, b0, acc[0][0]); acc[0][1] = MFMA(a0, b1, acc[0][1]);
            acc[1][0] = MFMA(a1, b0, acc[1][0]); acc[1][1] = MFMA(a1, b1, acc[1][1]);
        }
        const bf16_t* ud = c.UD(); bf16_t* mixp = c.MIX();
        float uv[2][16][2];
#pragma unroll
        for (int mi = 0; mi < 2; ++mi)
#pragma unroll
            for (int i = 0; i < 16; ++i) {
                const int t = mh * 64 + mi * 32 + crow(i, hh);
#pragma unroll
                for (int ni = 0; ni < 2; ++ni) uv[mi][i][ni] = bf2f(ud[(t0 + t) * 256 + g * 64 + ni * 32 + ln]);
            }
        __builtin_amdgcn_sched_barrier(0);
#pragma unroll
        for (int mi = 0; mi < 2; ++mi)
#pragma unroll
            for (int i = 0; i < 16; ++i) {
                const int t = mh * 64 + mi * 32 + crow(i, hh);
                const float bsv = c.bs()[g * 128 + t];
#pragma unroll
                for (int ni = 0; ni < 2; ++ni) mixp[(t0 + t) * DM + 768 + g * 64 + ni * 32 + ln] = f2bf(uv[mi][i][ni] * (acc[mi][ni][i] + bsv));
            }
    }
}

DI void conv_weight(const float* __restrict__ W, int K, int N, const float* __restrict__ g, bf16_t* __restrict__ Wt, int nmode, float* tile, int vb, int G) {
    const int tid = otid();
    const int tk = K >> 6, tn = N >> 6;
    for (int t = vb; t < tk * tn; t += G) {
        const int k0 = (t / tn) * 64, n0 = (t % tn) * 64;
        __syncthreads();
#pragma unroll
        for (int j = 0; j < 4; ++j) {
            const int idx = tid + 256 * j, r = idx >> 4, c4 = idx & 15;
            f32x4 v = *(const f32x4*)(W + (size_t)(k0 + r) * N + n0 + c4 * 4);
            const float sc = g ? g[k0 + r] : 1.0f;
            tile[r * 65 + c4 * 4 + 0] = v[0] * sc; tile[r * 65 + c4 * 4 + 1] = v[1] * sc; tile[r * 65 + c4 * 4 + 2] = v[2] * sc; tile[r * 65 + c4 * 4 + 3] = v[3] * sc;
        }
        __syncthreads();
#pragma unroll
        for (int j = 0; j < 2; ++j) {
            const int idx = tid + 256 * j, n = idx >> 3, kc = (idx & 7) * 8;
            u32x4 pk;
            pk.x = pk2(tile[(kc + 0) * 65 + n], tile[(kc + 1) * 65 + n]); pk.y = pk2(tile[(kc + 2) * 65 + n], tile[(kc + 3) * 65 + n]);
            pk.z = pk2(tile[(kc + 4) * 65 + n], tile[(kc + 5) * 65 + n]); pk.w = pk2(tile[(kc + 6) * 65 + n], tile[(kc + 7) * 65 + n]);
            const int ng = n0 + n;
            const int np = nmode == 0 ? ng : ((ng >> 5) * 64 + (nmode == 2 ? 32 : 0) + (ng & 31));
            *(u32x4*)(Wt + (size_t)np * K + k0 + kc) = pk;
        }
    }
}

#define XB_TMO      128
#define XB_XCNT(j)  (256  + 64 * (j))
#define XB_XSUB(j)  (1280 + 64 * (j))
#define XB_XGEN(j)  (2304 + 64 * (j))
#define XB_TOP      3328
#define XB_TOPGEN   3392
#define XCD_BAR_WORDS 3456
#define XB_SPIN_CAP (1u << 18)
#define LAS __attribute__((address_space(3)))
DI unsigned xb_ld(unsigned* p)              { return __hip_atomic_load(p, __ATOMIC_RELAXED, __HIP_MEMORY_SCOPE_AGENT); }
DI unsigned xb_add(unsigned* p, unsigned v) { return __hip_atomic_fetch_add(p, v, __ATOMIC_RELAXED, __HIP_MEMORY_SCOPE_AGENT); }
DI unsigned xb_xcc_id() { return (unsigned)__builtin_amdgcn_s_getreg((3 << 11) | 20) & 0xFu; }
#define XB_SPIN(cond, bar) do { unsigned _sp = 0; while (cond) { __builtin_amdgcn_s_sleep(1); \
    if ((++_sp & 255u) == 0u) { if (xb_ld(&(bar)[XB_TMO])) break; if (_sp > XB_SPIN_CAP) { atomicAdd(&(bar)[XB_TMO], 1u); break; } } } } while (0)
struct XcdBarrier { unsigned* bar; unsigned x; volatile LAS unsigned* st; };
DI XcdBarrier xcd_barrier_post(unsigned* bar, volatile LAS unsigned* st) {
    XcdBarrier b; b.bar = bar; b.x = xb_xcc_id(); b.st = st;
    if (threadIdx.x == 0) (void)xb_add(&bar[XB_XCNT(b.x)], 1u);
    return b;
}
DI void xcd_barrier_complete(unsigned* bar, unsigned x, unsigned& nloc, unsigned& nx) {
    const unsigned G = gridDim.x * gridDim.y * gridDim.z;
    unsigned sum, cnt, mine, sp = 0u;
    for (;;) {
        sum = 0u; cnt = 0u; mine = 0u;
#pragma unroll
        for (unsigned j = 0; j < 16; ++j) { const unsigned c = xb_ld(&bar[XB_XCNT(j)]); sum += c; cnt += (c > 0u) ? 1u : 0u; mine = (j == x) ? c : mine; }
        if (sum == G) break;
        __builtin_amdgcn_s_sleep(1);
        if ((++sp & 255u) == 0u) { if (xb_ld(&bar[XB_TMO])) break; if (sp > XB_SPIN_CAP) { atomicAdd(&bar[XB_TMO], 1u); break; } }
    }
    nloc = mine > 0u ? mine : 1u; nx = cnt > 0u ? cnt : 1u;
}
DI void xcd_barrier(const XcdBarrier& b) {
    asm volatile("s_waitcnt vmcnt(0)" ::: "memory");
    __syncthreads();
    if (threadIdx.x == 0) {
        unsigned* bar = b.bar;
        __builtin_amdgcn_s_waitcnt(0);
        unsigned nloc = b.st[0], nx = b.st[1];
        if (nloc == 0u) { xcd_barrier_complete(bar, b.x, nloc, nx); b.st[0] = nloc; b.st[1] = nx; }
        const unsigned old = xb_add(&bar[XB_XSUB(b.x)], 1u);
        const unsigned gen = old / nloc;
        if (old + 1u == (gen + 1u) * nloc) {
            __builtin_amdgcn_fence(__ATOMIC_RELEASE, "agent");
            asm volatile("s_waitcnt vmcnt(0)" ::: "memory");
            const unsigned og = xb_add(&bar[XB_TOP], 1u);
            const unsigned tg = og / nx;
            if (og + 1u == (tg + 1u) * nx) xb_add(&bar[XB_TOPGEN], 1u);
            else XB_SPIN(xb_ld(&bar[XB_TOPGEN]) == tg, bar);
            __builtin_amdgcn_fence(__ATOMIC_ACQUIRE, "agent");
            xb_add(&bar[XB_XGEN(b.x)], 1u);
            asm volatile("s_waitcnt vmcnt(0)" ::: "memory");
        } else {
            XB_SPIN(xb_ld(&bar[XB_XGEN(b.x)]) == gen, bar);
            __builtin_amdgcn_fence(__ATOMIC_ACQUIRE, "agent");
            asm volatile("s_waitcnt vmcnt(0)" ::: "memory");
        }
    }
    __syncthreads();
}

DI int take_tile(unsigned* q, int per_q, int home, int& tried, volatile int* sh) {
    __syncthreads();
    if (otid() == 0) {
        int t = -1;
        while (tried < 8) {
            const int qi = (home + tried) & 7;
            const unsigned v = __hip_atomic_fetch_add(q + qi * 16, 1u, __ATOMIC_RELAXED, __HIP_MEMORY_SCOPE_AGENT);
            if (v < (unsigned)per_q) { t = qi * per_q + (int)v; break; }
            ++tried;
        }
        *sh = t;
    }
    __syncthreads();
    return *sh;
}

DI void gsync(cg::grid_group& grid) { __threadfence(); grid.sync(); __threadfence(); }

__global__ void __launch_bounds__(256, 2) fwd_megakernel(KP P) {
    cg::grid_group grid = cg::this_grid();
    __shared__ __attribute__((aligned(16))) bf16_t lds[LDS_BYTES / 2];
    __shared__ int sh_item;
    __shared__ uint4 xb_words;
    if (threadIdx.x == 0) xb_words = make_uint4(0u, 0u, 0u, 0u);
    __syncthreads();
    const XcdBarrier xb = xcd_barrier_post((unsigned*)(P.ws + OFF_ROPE), (volatile LAS unsigned*)&xb_words);
    const int tid = otid(), lane = tid & 63, w = __builtin_amdgcn_readfirstlane(tid >> 6);
    const int G = gridDim.x, bid = blockIdx.x;
    const int vb = (G & 7) == 0 ? ((bid & 7) * (G >> 3) + (bid >> 3)) : bid;
    unsigned char* ws = P.ws;
    bf16_t* Wb = (bf16_t*)(ws + OFF_W);
    bf16_t* hb0 = (bf16_t*)(ws + OFF_HB0);
    bf16_t* hb1 = (bf16_t*)(ws + OFF_HB1);
    unsigned char* R = ws + OFF_R;
    float* rowss = (float*)(ws + OFF_ROWSS);
    unsigned* ctl = (unsigned*)(ws + OFF_WS);
    unsigned* qcnt = ctl + 128;

    for (int l = 0; l < DEPTH; ++l) {
        bf16_t* wl = Wb + (size_t)l * WL_TOT;
        float* tile = (float*)lds;
        conv_weight(P.in[3] + (size_t)l * DM * PROJ, DM, PROJ, P.in[2] + l * DM, wl + WL_IN, 0, tile, vb, G);
        conv_weight(P.in[14] + (size_t)l * DM * DM, DM, DM, nullptr, wl + WL_OUT, 0, tile, vb, G);
        conv_weight(P.in[16] + (size_t)l * DM * FFN, DM, FFN, P.in[15] + l * DM, wl + WL_GU, 1, tile, vb, G);
        conv_weight(P.in[17] + (size_t)l * DM * FFN, DM, FFN, P.in[15] + l * DM, wl + WL_GU, 2, tile, vb, G);
        conv_weight(P.in[18] + (size_t)l * FFN * DM, FFN, DM, nullptr, wl + WL_DOWN, 0, tile, vb, G);
        conv_weight(P.in[20] + (size_t)l * DM * DM, DM, DM, P.in[19] + l * DM, wl + WL_PG, 0, tile, vb, G);
        conv_weight(P.in[21] + (size_t)l * PLE * DM, PLE, DM, nullptr, wl + WL_PP, 0, tile, vb, G);
    }
    {
        const float* x = P.in[0];
        for (int row = bid * 4 + w; row < NTOK; row += G * 4) {
            float ss = 0.f;
#pragma unroll
            for (int j = 0; j < 4; ++j) {
                const f32x4 v = *(const f32x4*)(x + (size_t)row * DM + j * 256 + lane * 4);
                ss += v[0] * v[0] + v[1] * v[1] + v[2] * v[2] + v[3] * v[3];
                u32x2 pk; pk.x = pk2(v[0], v[1]); pk.y = pk2(v[2], v[3]);
                *(u32x2*)(hb0 + (size_t)row * DM + j * 256 + lane * 4) = pk;
            }
#pragma unroll
            for (int o = 32; o > 0; o >>= 1) ss += __shfl_xor(ss, o);
            if (lane < 8) rowss[(size_t)row * 8 + lane] = lane == 0 ? ss : 0.f;
        }
    }
    if (bid == 0) for (int i = tid; i < 256 + 4 * 5 * 128; i += 256) ctl[i] = 0u;
    gsync(grid);

    bf16_t* hb_cur = hb0; bf16_t* hb_alt = hb1;
    for (int l = 0; l < DEPTH; ++l) {
        LC c; c.P = &P; c.ws = ws; c.hb_cur = hb_cur; c.hb_alt = hb_alt; c.l = l; c.pad_ = 0;
        for (int tried_ = 0;;) {
            const int t = take_tile(ctl + 256 + (l * 5 + 0) * 128, 2560 / 8, (int)xb.x & 7, tried_, &sh_item); if (t < 0) break;
            const int m0 = ((t / 160) * 8 + (t & 7)) * 256, n0 = ((t % 160) >> 3) * 128;
            const float rpre0 = rstd_pre(c.rs_mix(), m0), rpre1 = rstd_pre(c.rs_mix(), m0 + 128);
            f32x16 acc[4][2];
            gemm_kloop256(c.hb_cur, DM, c.w_in(), DM, DM, m0, n0, acc, lds);
            rstd_put(rpre0, (float*)lds);
            epi_proj(*(const f32x16 (*)[2][2])&acc[0], m0, n0, c, (const float*)lds, lds);
            __syncthreads();
            rstd_put(rpre1, (float*)lds);
            epi_proj(*(const f32x16 (*)[2][2])&acc[2], m0 + 128, n0, c, (const float*)lds, lds);
        }
        xcd_barrier(xb);
        for (;;) {
            __syncthreads();
            if (otid() == 0) sh_item = (int)atomicAdd(qcnt + l, 1u);
            __syncthreads();
            const int t = sh_item;
            if (t >= 2304) break;
            if (t < 256) attn_item_B(((t >> 7) * 4 + 3) * 128 + (t & 127), c, lds);
            else if (t < 768) attn_item_A(t - 256, c, lds);
            else if (t < 1536) { const int u = t - 768, hd = 2 - (u >> 8), v = u & 255; attn_item_B(((v >> 7) * 4 + hd) * 128 + (v & 127), c, lds); }
            else if (t < 2048) attn_item_C(t - 1536, c, lds);
            else sgu_item(t - 2048, c, lds);
        }
        xcd_barrier(xb);
        for (int tried_ = 0;;) {
            const int t = take_tile(ctl + 256 + (l * 5 + 1) * 128, 1024 / 8, (int)xb.x & 7, tried_, &sh_item); if (t < 0) break;
            const int m0 = ((t >> 6) * 8 + (t & 7)) * 256, n0 = ((t & 63) >> 3) * 128;
            f32x16 acc[4][2];
            gemm_kloop256(c.MIX(), DM, c.w_out(), DM, DM, m0, n0, acc, lds);
            epi_resid(*(const f32x16 (*)[2][2])&acc[0], m0, n0, c.hb_cur, c.hb_cur, c.rs_ffn(), lds);
            __syncthreads();
            epi_resid(*(const f32x16 (*)[2][2])&acc[2], m0 + 128, n0, c.hb_cur, c.hb_cur, c.rs_ffn(), lds);
        }
        xcd_barrier(xb);
        for (int tried_ = 0;;) {
            const int t = take_tile(ctl + 256 + (l * 5 + 2) * 128, 5632 / 8, (int)xb.x & 7, tried_, &sh_item); if (t < 0) break;
            const int m0 = ((t / 352) * 8 + (t & 7)) * 256, n0 = ((t % 352) >> 3) * 128;
            const float rpre0 = rstd_pre(c.rs_ffn(), m0), rpre1 = rstd_pre(c.rs_ffn(), m0 + 128);
            f32x16 acc[4][2];
            gemm_kloop256(c.hb_cur, DM, c.w_gu(), DM, DM, m0, n0, acc, lds);
            rstd_put(rpre0, (float*)lds);
            epi_swiglu(*(const f32x16 (*)[2][2])&acc[0], m0, n0, (const float*)lds, c.ACT(), lds);
            __syncthreads();
            rstd_put(rpre1, (float*)lds);
            epi_swiglu(*(const f32x16 (*)[2][2])&acc[2], m0 + 128, n0, (const float*)lds, c.ACT(), lds);
        }
        xcd_barrier(xb);
        for (int tried_ = 0;;) {
            const int t = take_tile(ctl + 256 + (l * 5 + 3) * 128, 1024 / 8, (int)xb.x & 7, tried_, &sh_item); if (t < 0) break;
            const int m0 = ((t >> 6) * 8 + (t & 7)) * 256, n0 = ((t & 63) >> 3) * 128;
            f32x16 acc[4][2];
            gemm_kloop256(c.ACT(), FFN, c.w_down(), FFN, FFN, m0, n0, acc, lds);
            epi_resid(*(const f32x16 (*)[2][2])&acc[0], m0, n0, c.hb_cur, c.hb_cur, c.rs_ple(), lds);
            __syncthreads();
            epi_resid(*(const f32x16 (*)[2][2])&acc[2], m0 + 128, n0, c.hb_cur, c.hb_cur, c.rs_ple(), lds);
        }
        xcd_barrier(xb);
            for (int tried_ = 0;;) { const int t = take_tile(ctl + 256 + (l * 5 + 4) * 128, 2048 / 8, (int)xb.x & 7, tried_, &sh_item); if (t < 0) break;

            const int m0 = ((t >> 6) * 8 + (t & 7)) * 128, n0 = ((t & 63) >> 3) * 128;
            f32x16 acc[2][2];
            {
                const float rpre = rstd_pre(c.rs_ple(), m0);
                f32x16 gacc[2][2];
                { u32x4 ra[4], rb[4]; gemm_kloop<false>(c.hb_cur, DM, c.w_pg(), DM, DM, m0, n0, gacc, lds, ra, rb, false, false, 0, 0); }
                rstd_put(rpre, (float*)lds);
                epi_gate_stage(gacc, (const float*)lds, lds);
            }
            gemm_kloop_p(c.p(), c.w_pp(), m0, n0, acc, lds);
            epi_gate_apply(acc, lds);
            __syncthreads();
            epi_resid(acc, m0, n0, c.hb_cur, c.hb_alt, c.rs_next(), lds);
        }
        xcd_barrier(xb);
        { bf16_t* tmp = hb_cur; hb_cur = hb_alt; hb_alt = tmp; }
    }
    {
        const float* gf = P.in[22];
        const float* rsf = rowss;
        const int tid2 = otid(), lane = tid2 & 63, w = __builtin_amdgcn_readfirstlane(tid2 >> 6);
        for (int row = bid * 4 + w; row < NTOK; row += G * 4) {
            float sm = 0.f;
            { const f32x4 a = *(const f32x4*)(rsf + (size_t)row * 8), b2 = *(const f32x4*)(rsf + (size_t)row * 8 + 4);
              sm = ((a[0] + a[1]) + (a[2] + a[3])) + ((b2[0] + b2[1]) + (b2[2] + b2[3])); }
            const float rstd = __builtin_amdgcn_rsqf(sm * (1.0f / DM) + 1e-6f);
#pragma unroll
            for (int j = 0; j < 2; ++j) {
                const int col = j * 512 + lane * 8;
                const u32x4 v = *(const u32x4*)(hb_cur + (size_t)row * DM + col);
                const f32x4 g0 = *(const f32x4*)(gf + col), g1 = *(const f32x4*)(gf + col + 4);
                f32x4 o0, o1;
                o0[0] = __uint_as_float(v.x << 16) * rstd * g0[0]; o0[1] = __uint_as_float(v.x & 0xffff0000u) * rstd * g0[1];
                o0[2] = __uint_as_float(v.y << 16) * rstd * g0[2]; o0[3] = __uint_as_float(v.y & 0xffff0000u) * rstd * g0[3];
                o1[0] = __uint_as_float(v.z << 16) * rstd * g1[0]; o1[1] = __uint_as_float(v.z & 0xffff0000u) * rstd * g1[1];
                o1[2] = __uint_as_float(v.w << 16) * rstd * g1[2]; o1[3] = __uint_as_float(v.w & 0xffff0000u) * rstd * g1[3];
                *(f32x4*)(P.out + (size_t)row * DM + col) = o0; *(f32x4*)(P.out + (size_t)row * DM + col + 4) = o1;
            }
        }
    }
}

extern "C" void kernel_launch(void* const* d_in, const int* in_sizes, int n_in, void* d_out, int out_size, void* d_ws, size_t ws_size, hipStream_t stream) {
    static int grid_blocks = 0;
    if (!grid_blocks) {
        int dev = 0, cus = 0, per_cu = 0;
        hipGetDevice(&dev);
        hipDeviceGetAttribute(&cus, hipDeviceAttributeMultiprocessorCount, dev);
        hipOccupancyMaxActiveBlocksPerMultiprocessor(&per_cu, fwd_megakernel, 256, 0);
        if (per_cu > 2) per_cu = 2;
        grid_blocks = cus * per_cu;
    }
    hipMemsetAsync((char*)d_ws + OFF_ROPE, 0, XCD_BAR_WORDS * sizeof(unsigned), stream);
    KP p{};
    for (int i = 0; i < 23; ++i) p.in[i] = (const float*)d_in[i];
    p.out = (float*)d_out; p.ws = (unsigned char*)d_ws;
    void* args[] = {&p};
    hipError_t e = hipLaunchCooperativeKernel((void*)fwd_megakernel, dim3(grid_blocks), dim3(256), args, 0, stream);
    if (e != hipSuccess) fprintf(stderr, "cooperative launch failed: %s (grid %d)\n", hipGetErrorString(e), grid_blocks);
}
```

```cpp
#include <hip/hip_runtime.h>
#include <hip/hip_cooperative_groups.h>
#include <cstdio>
#include <cstdint>
namespace cg = cooperative_groups;

typedef unsigned short bf16_t;
typedef short bf16x8 __attribute__((ext_vector_type(8)));
typedef float f32x16 __attribute__((ext_vector_type(16)));
typedef float f32x4 __attribute__((ext_vector_type(4)));
typedef float f32x2 __attribute__((ext_vector_type(2)));
typedef unsigned u32x4 __attribute__((ext_vector_type(4)));
typedef unsigned u32x2 __attribute__((ext_vector_type(2)));
typedef __bf16 bf2_t __attribute__((ext_vector_type(2)));
#define DI __device__ __forceinline__
#define MFMA(a, b, c) __builtin_amdgcn_mfma_f32_32x32x16_bf16((a), (b), (c), 0, 0, 0)

constexpr int SEQ = 16384, NTOK = 32768, DM = 1024, DEPTH = 4, FFN = 2816, PROJ = 2560, PLE = 256;
#ifndef MIXMASK
#define MIXMASK 15
#endif
constexpr float LOG2E = 1.4426950408889634f;
constexpr size_t MiB = 1u << 20;
constexpr size_t WL_IN = 0, WL_OUT = WL_IN + (size_t)PROJ * DM, WL_GU = WL_OUT + (size_t)DM * DM, WL_DOWN = WL_GU + (size_t)2 * FFN * DM,
                 WL_PG = WL_DOWN + (size_t)DM * FFN, WL_PP = WL_PG + (size_t)DM * DM, WL_TOT = WL_PP + (size_t)DM * PLE;
static_assert(WL_TOT * 2 == 26 * MiB, "weights per layer");
constexpr size_t OFF_W = 0, OFF_HB0 = 104 * MiB, OFF_HB1 = 168 * MiB, OFF_R = 232 * MiB, OFF_ROWSS = 488 * MiB, OFF_WS = 494 * MiB, OFF_ROPE = 495 * MiB;
constexpr size_t R_QA = 0, R_KA = 16 * MiB, R_VA = 24 * MiB, R_QB = 32 * MiB, R_KB = 48 * MiB, R_VB = 64 * MiB, R_QC = 80 * MiB, R_KC = 96 * MiB,
                 R_VC = 112 * MiB, R_UD = 128 * MiB, R_VD = 144 * MiB, R_MIX = 160 * MiB, R_STASH = 224 * MiB, R_ACT = 0;

struct KP { const float* in[23]; float* out; unsigned char* ws; };

DI unsigned pk2(float a, float b) { f32x2 v = {a, b}; bf2_t r = __builtin_convertvector(v, bf2_t); return __builtin_bit_cast(unsigned, r); }
DI bf16_t f2bf(float a) { __bf16 r = (__bf16)a; return __builtin_bit_cast(bf16_t, r); }
DI float bf2f(bf16_t v) { return __uint_as_float(((unsigned)v) << 16); }
DI float half_sum(float v) { v += __shfl_xor(v, 1); v += __shfl_xor(v, 2); v += __shfl_xor(v, 4); v += __shfl_xor(v, 8); v += __shfl_xor(v, 16); return v; }
DI int otid() { int t = threadIdx.x; asm volatile("" : "+v"(t) :: "memory"); return t; }
DI float opq(float x) { int u = __builtin_amdgcn_readfirstlane(__float_as_int(x)); asm volatile("" : "+s"(u)); return __int_as_float(u); }
DI float row_reduce32(float (&v)[32], int ln) {
#pragma unroll
    for (int j = 0; j < 16; ++j) { const bool up = (ln & 16) != 0; const float send = up ? v[j] : v[j + 16], keep = up ? v[j + 16] : v[j]; v[j] = keep + __shfl_xor(send, 16); }
#pragma unroll
    for (int j = 0; j < 8; ++j) { const bool up = (ln & 8) != 0; const float send = up ? v[j] : v[j + 8], keep = up ? v[j + 8] : v[j]; v[j] = keep + __shfl_xor(send, 8); }
#pragma unroll
    for (int j = 0; j < 4; ++j) { const bool up = (ln & 4) != 0; const float send = up ? v[j] : v[j + 4], keep = up ? v[j + 4] : v[j]; v[j] = keep + __shfl_xor(send, 4); }
#pragma unroll
    for (int j = 0; j < 2; ++j) { const bool up = (ln & 2) != 0; const float send = up ? v[j] : v[j + 2], keep = up ? v[j + 2] : v[j]; v[j] = keep + __shfl_xor(send, 2); }
    { const bool up = (ln & 1) != 0; const float send = up ? v[0] : v[1], keep = up ? v[1] : v[0]; v[0] = keep + __shfl_xor(send, 1); }
    return v[0];
}
DI int crow(int i, int hh) { return (i & 3) + 8 * (i >> 2) + 4 * hh; }

constexpr int LDT = 72;
constexpr int TILE_E = 128 * LDT;
constexpr int LDS_BYTES = 4 * TILE_E * 2;

template <bool AF32>
DI void gemm_kloop(const void* __restrict__ Ap, int lda, const bf16_t* __restrict__ Bt, int ldb, int K, int m0, int n0, f32x16 (&acc)[2][2], bf16_t* lds,
                   u32x4 (&ra)[4], u32x4 (&rb)[4], bool pre, bool nxt, int m0n, int n0n) {
    const int tid = otid(), lane = tid & 63, w = __builtin_amdgcn_readfirstlane(tid >> 6), wr = w >> 1, wc = w & 1;
    const int lr = tid >> 3, lc = (tid & 7) * 8;
#pragma unroll
    for (int mi = 0; mi < 2; ++mi)
#pragma unroll
        for (int ni = 0; ni < 2; ++ni)
#pragma unroll
            for (int i = 0; i < 16; ++i) acc[mi][ni][i] = 0.f;
    auto compute = [&](int buf) {
        const bf16_t* As = lds + buf * TILE_E + (wr * 64 + (lane & 31)) * LDT + (lane >> 5) * 8;
        const bf16_t* Bs = lds + (2 + buf) * TILE_E + (wc * 64 + (lane & 31)) * LDT + (lane >> 5) * 8;
#pragma unroll
        for (int ks = 0; ks < 4; ++ks) {
            const bf16x8 a0 = *(const bf16x8*)(As + ks * 16), a1 = *(const bf16x8*)(As + 32 * LDT + ks * 16);
            const bf16x8 b0 = *(const bf16x8*)(Bs + ks * 16), b1 = *(const bf16x8*)(Bs + 32 * LDT + ks * 16);
            acc[0][0] = MFMA(a0, b0, acc[0][0]); acc[0][1] = MFMA(a0, b1, acc[0][1]);
            acc[1][0] = MFMA(a1, b0, acc[1][0]); acc[1][1] = MFMA(a1, b1, acc[1][1]);
        }
    };
    const int KT = K >> 6;
    if (AF32) {
        f32x4 rf[4][2];
        auto gload = [&](int kt) {
#pragma unroll
            for (int j = 0; j < 4; ++j) {
                const int row = lr + 32 * j;
                const float* src = (const float*)Ap + (size_t)(m0 + row) * lda + kt * 64 + lc; rf[j][0] = *(const f32x4*)src; rf[j][1] = *(const f32x4*)(src + 4);
                rb[j] = *(const u32x4*)(Bt + (size_t)(n0 + row) * ldb + kt * 64 + lc);
            }
        };
        auto lstore = [&](int buf) {
            bf16_t* As = lds + buf * TILE_E; bf16_t* Bs = lds + (2 + buf) * TILE_E;
#pragma unroll
            for (int j = 0; j < 4; ++j) {
                const int row = lr + 32 * j;
                u32x4 v; v.x = pk2(rf[j][0][0], rf[j][0][1]); v.y = pk2(rf[j][0][2], rf[j][0][3]); v.z = pk2(rf[j][1][0], rf[j][1][1]); v.w = pk2(rf[j][1][2], rf[j][1][3]);
                *(u32x4*)(As + row * LDT + lc) = v;
                *(u32x4*)(Bs + row * LDT + lc) = rb[j];
            }
        };
        __syncthreads();
        gload(0); lstore(0); __syncthreads();
        for (int kt = 0; kt < KT; ++kt) {
            if (kt + 1 < KT) gload(kt + 1);
            __builtin_amdgcn_sched_barrier(0);
            compute(kt & 1);
            __builtin_amdgcn_sched_barrier(0);
            if (kt + 1 < KT) lstore((kt + 1) & 1);
            __syncthreads();
        }
        return;
    }
    u32x4 sa0[4], sb0[4], sa1[4], sb1[4];
    const bf16_t* Ag = (const bf16_t*)Ap + (size_t)(m0 + lr) * lda + lc;
    const bf16_t* Bg = Bt + (size_t)(n0 + lr) * ldb + lc;
    auto gl = [&](u32x4 (&xa)[4], u32x4 (&xb)[4], int kt) {
#pragma unroll
        for (int j = 0; j < 4; ++j) { xa[j] = *(const u32x4*)(Ag + (size_t)(32 * j) * lda + kt * 64); xb[j] = *(const u32x4*)(Bg + (size_t)(32 * j) * ldb + kt * 64); }
    };
    auto ls = [&](const u32x4 (&xa)[4], const u32x4 (&xb)[4], int buf) {
        bf16_t* As = lds + buf * TILE_E + lr * LDT + lc; bf16_t* Bs = lds + (2 + buf) * TILE_E + lr * LDT + lc;
#pragma unroll
        for (int j = 0; j < 4; ++j) { *(u32x4*)(As + 32 * j * LDT) = xa[j]; *(u32x4*)(Bs + 32 * j * LDT) = xb[j]; }
    };
    __syncthreads();
    gl(sa0, sb0, 0); gl(sa1, sb1, 1);
    ls(sa0, sb0, 0); __syncthreads();
    for (int kt = 0; kt < KT; kt += 2) {
        if (kt + 2 < KT) gl(sa0, sb0, kt + 2);
        __builtin_amdgcn_sched_barrier(0);
        compute(0);
        __builtin_amdgcn_sched_barrier(0);
        ls(sa1, sb1, 1);
        __syncthreads();
        if (kt + 3 < KT) gl(sa1, sb1, kt + 3);
        __builtin_amdgcn_sched_barrier(0);
        compute(1);
        __builtin_amdgcn_sched_barrier(0);
        if (kt + 2 < KT) ls(sa0, sb0, 0);
        __syncthreads();
    }
}

DI void gemm_kloop256(const bf16_t* __restrict__ A, int lda, const bf16_t* __restrict__ Bt, int ldb, int K, int m0, int n0, f32x16 (&acc)[4][2], bf16_t* lds) {
    const int tid = otid(), lane = tid & 63, w = __builtin_amdgcn_readfirstlane(tid >> 6), wr = w >> 1, wc = w & 1;
    const int lr = tid >> 3, lc = (tid & 7) * 8;
#pragma unroll
    for (int mi = 0; mi < 4; ++mi)
#pragma unroll
        for (int ni = 0; ni < 2; ++ni)
#pragma unroll
            for (int i = 0; i < 16; ++i) acc[mi][ni][i] = 0.f;
    u32x4 sa[8], sb[4];
    const bf16_t* Ag = A + (size_t)(m0 + lr) * lda + lc;
    const bf16_t* Bg = Bt + (size_t)(n0 + lr) * ldb + lc;
    auto gl = [&](int kt) {
#pragma unroll
        for (int j = 0; j < 8; ++j) sa[j] = *(const u32x4*)(Ag + (size_t)(32 * j) * lda + kt * 64);
#pragma unroll
        for (int j = 0; j < 4; ++j) sb[j] = *(const u32x4*)(Bg + (size_t)(32 * j) * ldb + kt * 64);
    };
    bf16_t* Aw = lds + lr * LDT + lc; bf16_t* Bw = lds + 256 * LDT + lr * LDT + lc;
    const bf16_t* Ar = lds + (wr * 64 + (lane & 31)) * LDT + (lane >> 5) * 8;
    const bf16_t* Br = lds + 256 * LDT + (wc * 64 + (lane & 31)) * LDT + (lane >> 5) * 8;
    const int KT = K >> 6;
    gl(0);
    for (int kt = 0; kt < KT; ++kt) {
        __syncthreads();
#pragma unroll
        for (int j = 0; j < 8; ++j) *(u32x4*)(Aw + 32 * j * LDT) = sa[j];
#pragma unroll
        for (int j = 0; j < 4; ++j) *(u32x4*)(Bw + 32 * j * LDT) = sb[j];
        __syncthreads();
        if (kt + 1 < KT) gl(kt + 1);
        __builtin_amdgcn_sched_barrier(0);
#pragma unroll
        for (int ks = 0; ks < 4; ++ks) {
            const bf16x8 b0 = *(const bf16x8*)(Br + ks * 16), b1 = *(const bf16x8*)(Br + 32 * LDT + ks * 16);
            const bf16x8 a0 = *(const bf16x8*)(Ar + ks * 16), a1 = *(const bf16x8*)(Ar + 32 * LDT + ks * 16);
            const bf16x8 a2 = *(const bf16x8*)(Ar + 128 * LDT + ks * 16), a3 = *(const bf16x8*)(Ar + 160 * LDT + ks * 16);
            acc[0][0] = MFMA(a0, b0, acc[0][0]); acc[0][1] = MFMA(a0, b1, acc[0][1]);
            acc[1][0] = MFMA(a1, b0, acc[1][0]); acc[1][1] = MFMA(a1, b1, acc[1][1]);
            acc[2][0] = MFMA(a2, b0, acc[2][0]); acc[2][1] = MFMA(a2, b1, acc[2][1]);
            acc[3][0] = MFMA(a3, b0, acc[3][0]); acc[3][1] = MFMA(a3, b1, acc[3][1]);
        }
        __builtin_amdgcn_sched_barrier(0);
    }
    __syncthreads();
}

DI void gemm_kloop_p(const float* __restrict__ Ap, const bf16_t* __restrict__ Bt, int m0, int n0, f32x16 (&acc)[2][2], bf16_t* lds) {
    const int tid = otid(), lane = tid & 63, w = __builtin_amdgcn_readfirstlane(tid >> 6), wr = w >> 1, wc = w & 1;
    const int lr = tid >> 3, lc = (tid & 7) * 8;
#pragma unroll
    for (int mi = 0; mi < 2; ++mi)
#pragma unroll
        for (int ni = 0; ni < 2; ++ni)
#pragma unroll
            for (int i = 0; i < 16; ++i) acc[mi][ni][i] = 0.f;
    f32x4 rf[4][2]; u32x4 rb[4];
    auto gload = [&](int kt) {
#pragma unroll
        for (int j = 0; j < 4; ++j) {
            const int row = lr + 32 * j;
            const float* src = Ap + (size_t)(m0 + row) * PLE + kt * 64 + lc; rf[j][0] = *(const f32x4*)src; rf[j][1] = *(const f32x4*)(src + 4);
            rb[j] = *(const u32x4*)(Bt + (size_t)(n0 + row) * PLE + kt * 64 + lc);
        }
    };
    bf16_t* As = lds + 2 * TILE_E; bf16_t* Bs = lds + 3 * TILE_E;
    gload(0);
    for (int kt = 0; kt < PLE / 64; ++kt) {
        __syncthreads();
#pragma unroll
        for (int j = 0; j < 4; ++j) {
            const int row = lr + 32 * j;
            u32x4 v; v.x = pk2(rf[j][0][0], rf[j][0][1]); v.y = pk2(rf[j][0][2], rf[j][0][3]); v.z = pk2(rf[j][1][0], rf[j][1][1]); v.w = pk2(rf[j][1][2], rf[j][1][3]);
            *(u32x4*)(As + row * LDT + lc) = v;
            *(u32x4*)(Bs + row * LDT + lc) = rb[j];
        }
        __syncthreads();
        if (kt + 1 < PLE / 64) gload(kt + 1);
        __builtin_amdgcn_sched_barrier(0);
        const bf16_t* Ar = As + (wr * 64 + (lane & 31)) * LDT + (lane >> 5) * 8;
        const bf16_t* Br = Bs + (wc * 64 + (lane & 31)) * LDT + (lane >> 5) * 8;
#pragma unroll
        for (int ks = 0; ks < 4; ++ks) {
            const bf16x8 a0 = *(const bf16x8*)(Ar + ks * 16), a1 = *(const bf16x8*)(Ar + 32 * LDT + ks * 16);
            const bf16x8 b0 = *(const bf16x8*)(Br + ks * 16), b1 = *(const bf16x8*)(Br + 32 * LDT + ks * 16);
            acc[0][0] = MFMA(a0, b0, acc[0][0]); acc[0][1] = MFMA(a0, b1, acc[0][1]);
            acc[1][0] = MFMA(a1, b0, acc[1][0]); acc[1][1] = MFMA(a1, b1, acc[1][1]);
        }
        __builtin_amdgcn_sched_barrier(0);
    }
}

DI float rstd_pre(const float* __restrict__ part, int m0) {
    const int tid = otid(), row = tid >> 1, half = tid & 1;
    const f32x4 a = *(const f32x4*)(part + (size_t)(m0 + row) * 8 + half * 4);
    float sm = (a[0] + a[1]) + (a[2] + a[3]);
    sm += __shfl_xor(sm, 1);
    return __builtin_amdgcn_rsqf(sm * (1.0f / DM) + 1e-6f);
}
DI void rstd_put(float v, float* rl) { rl[otid() >> 1] = v; __syncthreads(); }

DI void tile_rstd(const float* __restrict__ part, int m0, float* rl) {
    const int tid = otid(), row = tid >> 1, half = tid & 1;
    const f32x4 a = *(const f32x4*)(part + (size_t)(m0 + row) * 8 + half * 4);
    float sm = (a[0] + a[1]) + (a[2] + a[3]);
    sm += __shfl_xor(sm, 1);
    rl[row] = __builtin_amdgcn_rsqf(sm * (1.0f / DM) + 1e-6f);
    __syncthreads();
}

struct LC {
    const KP* P; unsigned char* ws; bf16_t *hb_cur, *hb_alt; int l; int pad_;
    DI unsigned char* R() const { return ws + OFF_R; }
    DI const bf16_t* wl() const { return (const bf16_t*)(ws + OFF_W) + (size_t)l * WL_TOT; }
    DI const bf16_t* w_in() const { return wl() + WL_IN; }
    DI const bf16_t* w_out() const { return wl() + WL_OUT; }
    DI const bf16_t* w_gu() const { return wl() + WL_GU; }
    DI const bf16_t* w_down() const { return wl() + WL_DOWN; }
    DI const bf16_t* w_pg() const { return wl() + WL_PG; }
    DI const bf16_t* w_pp() const { return wl() + WL_PP; }
    DI const float* wsf() const { return P->in[12] + (size_t)l * 4 * 128 * 128; }
    DI bf16_t* QA() const { return (bf16_t*)(R() + R_QA); }
    DI bf16_t* KA() const { return (bf16_t*)(R() + R_KA); }
    DI bf16_t* VA() const { return (bf16_t*)(R() + R_VA); }
    DI bf16_t* QB() const { return (bf16_t*)(R() + R_QB); }
    DI bf16_t* KB() const { return (bf16_t*)(R() + R_KB); }
    DI bf16_t* VB() const { return (bf16_t*)(R() + R_VB); }
    DI bf16_t* QC() const { return (bf16_t*)(R() + R_QC); }
    DI bf16_t* KC() const { return (bf16_t*)(R() + R_KC); }
    DI bf16_t* VC() const { return (bf16_t*)(R() + R_VC); }
    DI bf16_t* UD() const { return (bf16_t*)(R() + R_UD); }
    DI bf16_t* VD() const { return (bf16_t*)(R() + R_VD); }
    DI bf16_t* MIX() const { return (bf16_t*)(R() + R_MIX); }
    DI bf16_t* ACT() const { return (bf16_t*)(R() + R_ACT); }
    DI float* stash() const { return (float*)(R() + R_STASH); }
    DI float* rs_mix() const { return (float*)(ws + OFF_ROWSS); }
    DI float* rs_ffn() const { return (float*)(ws + OFF_ROWSS) + (size_t)8 * NTOK; }
    DI float* rs_ple() const { return (float*)(ws + OFF_ROWSS) + (size_t)16 * NTOK; }
    DI float* rs_next() const { return (float*)(ws + OFF_ROWSS); }
    DI const float* aqn() const { return P->in[4] + l * 64; }
    DI const float* akn() const { return P->in[5] + l * 64; }
    DI const float* bsub() const { return P->in[8] + l * 64; }
    DI const float* rpb() const { return P->in[9] + (size_t)l * 4 * 15 * 31; }
    DI const float* lng() const { return P->in[10] + l * 256; }
    DI const float* lnb() const { return P->in[11] + l * 256; }
    DI const float* bs() const { return P->in[13] + l * 512; }
    DI const float* p() const { return P->in[1] + (size_t)l * NTOK * PLE; }
    DI const float* lamp() const { return P->in[6] + l * 64; }
    DI const float* lamp2() const { return P->in[7] + l * 64; }
    DI unsigned* nmax() const { return (unsigned*)(ws + OFF_WS) + l * 32; }
    DI const float* res_src() const { return l == 0 ? P->in[0] : (const float*)P->out; }
    DI float* out() const { return P->out; }
    DI float lam_init() const { return 0.8f - 0.6f * __expf(-0.3f * (float)l); }
};

DI void store_vt(bf16_t* base, int d, int srow, float v0, float v1, float v2, float v3) {
    const int g = (srow >> 2) & 3, gp = ((g & 1) << 1) | (g >> 1);
    const int pos = (srow & ~15) + gp * 4;
    u32x2 pk; pk.x = pk2(v0, v1); pk.y = pk2(v2, v3);
    *(u32x2*)(base + (size_t)d * SEQ + pos) = pk;
}

DI float gelu_exact(float x) { return 0.5f * x * (1.0f + erff(x * 0.70710678118654752f)); }

DI void epi_proj(const f32x16 (&acc)[2][2], int m0, int n0, const LC& c, const float* rl, bf16_t* lds) {
    constexpr int TL = 136;
    const int tid = otid(), lane = tid & 63, w = __builtin_amdgcn_readfirstlane(tid >> 6), wr = w >> 1, wc = w & 1, ln = lane & 31, hh = lane >> 5;
    bf16_t* T = lds + 512;
    const int b = m0 / SEQ, sbase = m0 - b * SEQ;
    int mode, sec0, nh; bf16_t* base; float osc = 1.0f;
    if (n0 < 256)       { mode = 4; sec0 = 0;    nh = 4; base = c.QA(); osc = 0.125f * LOG2E; }
    else if (n0 < 384)  { mode = 4; sec0 = 256;  nh = 2; base = c.KA(); }
    else if (n0 < 512)  { mode = 2; sec0 = 384;  nh = 2; base = c.VA(); }
    else if (n0 < 768)  { mode = 1; sec0 = 512;  nh = 4; base = c.QB(); osc = 0.17677669529663687f * LOG2E; }
    else if (n0 < 1024) { mode = 1; sec0 = 768;  nh = 4; base = c.KB(); }
    else if (n0 < 1280) { mode = 2; sec0 = 1024; nh = 4; base = c.VB(); }
    else if (n0 < 1536) { mode = 0; sec0 = 1280; nh = 4; base = c.QC(); osc = 0.125f * LOG2E; }
    else if (n0 < 1792) { mode = 0; sec0 = 1536; nh = 4; base = c.KC(); }
    else if (n0 < 2048) { mode = 2; sec0 = 1792; nh = 4; base = c.VC(); }
    else if (n0 < 2304) { mode = 3; sec0 = 2048; nh = 1; base = c.UD(); }
    else                { mode = 3; sec0 = 2304; nh = 1; base = c.VD(); }
    const int lr0 = wr * 64, lc0 = wc * 64 + ln;
    if (mode == 4) {
        const bool isq = n0 < 256;
        const float* gn = isq ? c.aqn() : c.akn();
        const float g0 = gn[ln], g1 = gn[32 + ln];
        const float rinv = __builtin_amdgcn_exp2f(-(float)(ln & 15) * (13.287712379549449f / 16.0f)) * 0.15915494309189535f;
        float ssq[32];
#pragma unroll
        for (int mi = 0; mi < 2; ++mi)
#pragma unroll
            for (int i = 0; i < 16; ++i) {
                const float rstd = rl[lr0 + mi * 32 + crow(i, hh)];
                const float v0 = acc[mi][0][i] * rstd, v1 = acc[mi][1][i] * rstd;
                ssq[mi * 16 + i] = v0 * v0 + v1 * v1;
            }
        const float rnl = __builtin_amdgcn_rsqf(row_reduce32(ssq, ln) * (1.0f / 64.0f) + 1e-6f);
#pragma unroll
        for (int mi = 0; mi < 2; ++mi)
#pragma unroll
            for (int i = 0; i < 16; ++i) {
                const int lrow = lr0 + mi * 32 + crow(i, hh), s = sbase + lrow;
                const float rn = __shfl(rnl, (lane & 32) + mi * 16 + i) * rl[lrow];
                const float v0 = acc[mi][0][i] * rn * g0, v1 = acc[mi][1][i] * rn * g1;
                const float rev = (float)((ln < 16) ? (s >> 6) : (s & 63)) * rinv;
                const float fr = rev - rintf(rev);
                const float cs = __builtin_amdgcn_cosf(fr), sn = __builtin_amdgcn_sinf(fr);
                T[lrow * TL + lc0] = f2bf((v0 * cs - v1 * sn) * osc); T[lrow * TL + lc0 + 32] = f2bf((v1 * cs + v0 * sn) * osc);
            }
    } else if (mode == 2) {
#pragma unroll
        for (int mi = 0; mi < 2; ++mi)
#pragma unroll
            for (int q4 = 0; q4 < 4; ++q4) {
                const int lrow = lr0 + mi * 32 + q4 * 8 + hh * 4;
                const int g = (lrow >> 2) & 3, gp = ((g & 1) << 1) | (g >> 1), pos = (lrow & ~15) + gp * 4;
#pragma unroll
                for (int ni = 0; ni < 2; ++ni) {
                    u32x2 pk;
                    pk.x = pk2(acc[mi][ni][q4 * 4 + 0] * rl[lrow + 0], acc[mi][ni][q4 * 4 + 1] * rl[lrow + 1]);
                    pk.y = pk2(acc[mi][ni][q4 * 4 + 2] * rl[lrow + 2], acc[mi][ni][q4 * 4 + 3] * rl[lrow + 3]);
                    *(u32x2*)(T + (lc0 + ni * 32) * TL + pos) = pk;
                }
            }
    } else {
        float nq0[32], nq1[32];
#pragma unroll
        for (int mi = 0; mi < 2; ++mi)
#pragma unroll
            for (int i = 0; i < 16; ++i) {
                const int lrow = lr0 + mi * 32 + crow(i, hh);
                const float rstd = rl[lrow] * osc;
                float v0 = acc[mi][0][i] * rstd, v1 = acc[mi][1][i] * rstd;
                if (mode == 1) { nq0[mi * 16 + i] = v0 * v0; nq1[mi * 16 + i] = v1 * v1; }
                if (mode == 3) { v0 = gelu_exact(v0); v1 = gelu_exact(v1); }
                T[lrow * TL + lc0] = f2bf(v0); T[lrow * TL + lc0 + 32] = f2bf(v1);
            }
        if (mode == 1) {
            float mx0 = row_reduce32(nq0, ln), mx1 = row_reduce32(nq1, ln);
#pragma unroll
            for (int o = 32; o > 0; o >>= 1) { mx0 = fmaxf(mx0, __shfl_xor(mx0, o)); mx1 = fmaxf(mx1, __shfl_xor(mx1, o)); }
            const int hd = (n0 - sec0 + wc * 64) >> 6;
            unsigned* slot = c.nmax() + (((b * 4 + hd) * 2) * 2 + (sec0 == 768 ? 1 : 0));
            if (lane == 0) { atomicMax(slot, __float_as_uint(mx0)); atomicMax(slot + 2, __float_as_uint(mx1)); }
        }
    }
    __syncthreads();
#pragma unroll
    for (int j = 0; j < 8; ++j) {
        const int cidx = tid + 256 * j, row = cidx >> 4, cc = cidx & 15;
        const u32x4 v = *(const u32x4*)(T + row * TL + cc * 8);
        bf16_t* dst;
        if (mode == 2) {
            const int colh = n0 - sec0 + row;
            dst = base + ((size_t)(b * nh + (colh >> 6)) * 64 + (colh & 63)) * SEQ + sbase + cc * 8;
        } else {
            const int colh = n0 - sec0 + cc * 8, sq = sbase + row;
            if (mode == 3) dst = base + (size_t)(b * SEQ + sq) * 256 + colh;
            else if (mode == 1) dst = base + ((size_t)((b * 4 + (colh >> 6)) * 2 + ((colh & 63) >> 5)) * SEQ + sq) * 32 + (colh & 31);
            else dst = base + ((size_t)(b * nh + (colh >> 6)) * SEQ + sq) * 64 + (colh & 63);
        }
        *(u32x4*)dst = v;
    }
}

DI void epi_resid(const f32x16 (&add)[2][2], int m0, int n0, const bf16_t* hres, bf16_t* hb, float* __restrict__ part_next, bf16_t* lds) {
    constexpr int SLD = 132;
    const int tid = otid(), lane = tid & 63, w = __builtin_amdgcn_readfirstlane(tid >> 6), wr = w >> 1, wc = w & 1, ln = lane & 31, hh = lane >> 5;
    float* S = (float*)lds + 256;
#pragma unroll
    for (int mi = 0; mi < 2; ++mi)
#pragma unroll
        for (int ni = 0; ni < 2; ++ni)
#pragma unroll
            for (int i = 0; i < 16; ++i) S[(wr * 64 + mi * 32 + crow(i, hh)) * SLD + wc * 64 + ni * 32 + ln] = add[mi][ni][i];
    __syncthreads();
    const int cc = tid & 31, r0 = tid >> 5;
    const bf16_t* rp = hres + (size_t)(m0 + r0) * DM + n0 + cc * 4;
    u32x2 rv[16];
#pragma unroll
    for (int j = 0; j < 16; ++j) rv[j] = *(const u32x2*)(rp + (size_t)j * 8 * DM);
    __builtin_amdgcn_sched_barrier(0);
    float ssq[16];
#pragma unroll
    for (int j = 0; j < 16; ++j) {
        const int row = r0 + 8 * j;
        const f32x4 a = *(const f32x4*)(S + row * SLD + cc * 4);
        f32x4 h;
        h[0] = __uint_as_float(rv[j].x << 16) + a[0]; h[1] = __uint_as_float(rv[j].x & 0xffff0000u) + a[1];
        h[2] = __uint_as_float(rv[j].y << 16) + a[2]; h[3] = __uint_as_float(rv[j].y & 0xffff0000u) + a[3];
        u32x2 pk; pk.x = pk2(h[0], h[1]); pk.y = pk2(h[2], h[3]);
        *(u32x2*)(hb + (size_t)(m0 + row) * DM + n0 + cc * 4) = pk;
        ssq[j] = (h[0] * h[0] + h[1] * h[1]) + (h[2] * h[2] + h[3] * h[3]);
    }
#pragma unroll
    for (int j = 0; j < 8; ++j) { const bool up = (ln & 16) != 0; const float send = up ? ssq[j] : ssq[j + 8], keep = up ? ssq[j + 8] : ssq[j]; ssq[j] = keep + __shfl_xor(send, 16); }
#pragma unroll
    for (int j = 0; j < 4; ++j) { const bool up = (ln & 8) != 0; const float send = up ? ssq[j] : ssq[j + 4], keep = up ? ssq[j + 4] : ssq[j]; ssq[j] = keep + __shfl_xor(send, 8); }
#pragma unroll
    for (int j = 0; j < 2; ++j) { const bool up = (ln & 4) != 0; const float send = up ? ssq[j] : ssq[j + 2], keep = up ? ssq[j + 2] : ssq[j]; ssq[j] = keep + __shfl_xor(send, 4); }
    { const bool up = (ln & 2) != 0; const float send = up ? ssq[0] : ssq[1], keep = up ? ssq[1] : ssq[0]; ssq[0] = keep + __shfl_xor(send, 2); }
    const float tot = ssq[0] + __shfl_xor(ssq[0], 1);
    if ((ln & 1) == 0) part_next[(size_t)(m0 + r0 + 8 * (ln >> 1)) * 8 + (n0 >> 7)] = tot;
}

DI void epi_swiglu(const f32x16 (&acc)[2][2], int m0, int n0, const float* rl, bf16_t* __restrict__ act, bf16_t* lds) {
    constexpr int TL = 72;
    const int tid = otid(), lane = tid & 63, w = __builtin_amdgcn_readfirstlane(tid >> 6), wr = w >> 1, wc = w & 1, ln = lane & 31, hh = lane >> 5;
    bf16_t* T = lds + 512;
#pragma unroll
    for (int mi = 0; mi < 2; ++mi)
#pragma unroll
        for (int i = 0; i < 16; ++i) {
            const int row = wr * 64 + mi * 32 + crow(i, hh);
            const float rstd = rl[row];
            const float gv = acc[mi][0][i] * rstd, uv = acc[mi][1][i] * rstd;
            const float sg = gv * __builtin_amdgcn_rcpf(1.0f + __expf(-gv));
            T[row * TL + wc * 32 + ln] = f2bf(sg * uv);
        }
    __syncthreads();
#pragma unroll
    for (int j = 0; j < 4; ++j) {
        const int cidx = tid + 256 * j, row = cidx >> 3, cc = cidx & 7;
        *(u32x4*)(act + (size_t)(m0 + row) * FFN + (n0 >> 1) + cc * 8) = *(const u32x4*)(T + row * TL + cc * 8);
    }
}

DI void epi_gate_stage(const f32x16 (&g)[2][2], const float* rl, bf16_t* lds) {
    const int tid = otid(), lane = tid & 63, w = __builtin_amdgcn_readfirstlane(tid >> 6), wr = w >> 1, wc = w & 1, ln = lane & 31, hh = lane >> 5;
    bf16_t* T = lds + 512;
#pragma unroll
    for (int mi = 0; mi < 2; ++mi)
#pragma unroll
        for (int i = 0; i < 16; ++i) {
            const int lrow = wr * 64 + mi * 32 + crow(i, hh);
            const float rstd = rl[lrow];
            T[lrow * 136 + wc * 64 + ln] = f2bf(__builtin_amdgcn_rcpf(1.0f + __expf(-g[mi][0][i] * rstd)));
            T[lrow * 136 + wc * 64 + 32 + ln] = f2bf(__builtin_amdgcn_rcpf(1.0f + __expf(-g[mi][1][i] * rstd)));
        }
}
DI void epi_gate_apply(f32x16 (&acc)[2][2], const bf16_t* lds) {
    const int tid = otid(), lane = tid & 63, w = __builtin_amdgcn_readfirstlane(tid >> 6), wr = w >> 1, wc = w & 1, ln = lane & 31, hh = lane >> 5;
    const bf16_t* T = lds + 512;
#pragma unroll
    for (int mi = 0; mi < 2; ++mi)
#pragma unroll
        for (int i = 0; i < 16; ++i) {
            const int lrow = wr * 64 + mi * 32 + crow(i, hh);
            acc[mi][0][i] *= bf2f(T[lrow * 136 + wc * 64 + ln]);
            acc[mi][1][i] *= bf2f(T[lrow * 136 + wc * 64 + 32 + ln]);
        }
}

template <int DQK, int MODE>
DI void flash_block(const bf16_t* __restrict__ Qg, const bf16_t* __restrict__ Kg, const bf16_t* __restrict__ Vtg, int qbase, int kbeg, int kend,
                    float slope2, const float* __restrict__ rpbh, f32x16 (&O)[2][2], float (&lsum)[2], bf16_t* lds) {
    constexpr int KLD = DQK + 8, NKS = DQK / 16, KCH = DQK / 8, KJ = (64 * KCH) / 256;
    const int tid = otid(), lane = tid & 63, w = __builtin_amdgcn_readfirstlane(tid >> 6), ln = lane & 31, hh = lane >> 5;
    const int qw = qbase + w * 64;
    bf16x8 qf[2][NKS];
#pragma unroll
    for (int qi = 0; qi < 2; ++qi)
#pragma unroll
        for (int ks = 0; ks < NKS; ++ks) qf[qi][ks] = *(const bf16x8*)(Qg + (size_t)(qw + qi * 32 + ln) * DQK + ks * 16 + hh * 8);
    float m[2] = {-1e30f, -1e30f};
    lsum[0] = 0.f; lsum[1] = 0.f;
#pragma unroll
    for (int a = 0; a < 2; ++a)
#pragma unroll
        for (int b2 = 0; b2 < 2; ++b2)
#pragma unroll
            for (int i = 0; i < 16; ++i) O[a][b2][i] = 0.f;
    int r = 0, rs = 0;
    if (MODE == 2) { r = qw >> 6; rs = min(max(r - 4, 0), 248); }
    bf16_t* Ks = lds; bf16_t* Vs = lds + 2 * 64 * KLD;
    float* nat = (float*)(lds + 2 * 64 * KLD + 2 * 64 * 72);
    u32x4 rk[KJ], rv[2];
    auto gload = [&](int key0) {
#pragma unroll
        for (int j = 0; j < KJ; ++j) { const int cidx = tid + 256 * j, row = cidx / KCH, cc = cidx % KCH; rk[j] = *(const u32x4*)(Kg + (size_t)(key0 + row) * DQK + cc * 8); }
#pragma unroll
        for (int j = 0; j < 2; ++j) { const int cidx = tid + 256 * j, row = cidx >> 3, cc = cidx & 7; rv[j] = *(const u32x4*)(Vtg + (size_t)row * SEQ + key0 + cc * 8); }
    };
    auto lstore = [&](int buf) {
#pragma unroll
        for (int j = 0; j < KJ; ++j) { const int cidx = tid + 256 * j, row = cidx / KCH, cc = cidx % KCH; *(u32x4*)(Ks + buf * 64 * KLD + row * KLD + cc * 8) = rk[j]; }
#pragma unroll
        for (int j = 0; j < 2; ++j) { const int cidx = tid + 256 * j, row = cidx >> 3, cc = cidx & 7; *(u32x4*)(Vs + buf * 64 * 72 + row * 72 + cc * 8) = rv[j]; }
    };
    __syncthreads();
    if (MODE == 2) {
        for (int e = tid; e < 15 * 128; e += 256) { const int dc = (e & 127) - 48; nat[e] = (dc >= 0 && dc < 31) ? rpbh[(e >> 7) * 31 + dc] * LOG2E : 0.f; }
    }
    gload(kbeg); lstore(0); __syncthreads();
    const int nt = (kend - kbeg) >> 6;
    for (int it = 0; it < nt; ++it) {
        const int key0 = kbeg + it * 64;
        if (it + 1 < nt) gload(key0 + 64);
        __builtin_amdgcn_sched_barrier(0);
        bool active = true;
        if (MODE == 2) { const int kr = key0 >> 6; active = (kr >= rs) && (kr < rs + 8); }
        if (active) {
            const int buf = it & 1;
            const bf16_t* kp = Ks + buf * 64 * KLD + ln * KLD + hh * 8;
            const bf16_t* vp = Vs + buf * 64 * 72 + ln * 72 + hh * 8;
#pragma unroll
            for (int kt = 0; kt < 2; ++kt) {
                f32x16 s[2];
#pragma unroll
                for (int b2 = 0; b2 < 2; ++b2)
#pragma unroll
                    for (int i = 0; i < 16; ++i) s[b2][i] = 0.f;
#pragma unroll
                for (int ks = 0; ks < NKS; ++ks) {
                    const bf16x8 kf = *(const bf16x8*)(kp + kt * 32 * KLD + ks * 16);
                    s[0] = MFMA(kf, qf[0][ks], s[0]);
                    s[1] = MFMA(kf, qf[1][ks], s[1]);
                }
                if (MODE == 1) {
#pragma unroll
                    for (int qi = 0; qi < 2; ++qi) {
                        const float base = (float)(qw + qi * 32 + ln - (key0 + kt * 32 + hh * 4));
#pragma unroll
                        for (int i = 0; i < 16; ++i) s[qi][i] -= slope2 * fabsf(base - (float)((i & 3) + 8 * (i >> 2)));
                    }
                }
                if (MODE == 2) {
                    const int dr = (key0 >> 6) - r + 7;
#pragma unroll
                    for (int qi = 0; qi < 2; ++qi) {
                        const int qc = qi * 32 + ln, cs = min(max(qc - 8, 0), 48);
                        const float* tb = nat + dr * 128 + (kt * 32 + 4 * hh - qc + 15 + 48);
#pragma unroll
                        for (int i = 0; i < 16; ++i) {
                            const int kc = kt * 32 + crow(i, hh);
                            const bool valid = (kc >= cs) && (kc < cs + 16);
                            const float bias = tb[(i & 3) + 8 * (i >> 2)];
                            s[qi][i] = valid ? (s[qi][i] + bias) : -1e30f;
                        }
                    }
                }
                float alpha[2]; bool chg = false;
#pragma unroll
                for (int qi = 0; qi < 2; ++qi) {
                    float mx = s[qi][0];
#pragma unroll
                    for (int i = 1; i < 16; ++i) mx = fmaxf(mx, s[qi][i]);
                    mx = fmaxf(mx, __shfl_xor(mx, 32));
                    const float mnew = fmaxf(m[qi], mx);
                    alpha[qi] = __builtin_amdgcn_exp2f(m[qi] - mnew);
                    chg = chg || (mnew > m[qi]);
                    m[qi] = mnew;
                }
                if (__any(chg)) {
#pragma unroll
                    for (int qi = 0; qi < 2; ++qi) {
                        lsum[qi] *= alpha[qi];
#pragma unroll
                        for (int dt = 0; dt < 2; ++dt)
#pragma unroll
                            for (int i = 0; i < 16; ++i) O[dt][qi][i] *= alpha[qi];
                    }
                }
                bf16x8 pf[2][2];
#pragma unroll
                for (int qi = 0; qi < 2; ++qi) {
                    float ls = 0.f;
#pragma unroll
                    for (int i = 0; i < 16; ++i) { const float p = __builtin_amdgcn_exp2f(s[qi][i] - m[qi]); s[qi][i] = p; ls += p; }
#pragma unroll
                    for (int s2 = 0; s2 < 2; ++s2) {
                        u32x4 pk;
                        pk.x = pk2(s[qi][8 * s2 + 0], s[qi][8 * s2 + 1]); pk.y = pk2(s[qi][8 * s2 + 2], s[qi][8 * s2 + 3]);
                        pk.z = pk2(s[qi][8 * s2 + 4], s[qi][8 * s2 + 5]); pk.w = pk2(s[qi][8 * s2 + 6], s[qi][8 * s2 + 7]);
                        pf[s2][qi] = __builtin_bit_cast(bf16x8, pk);
                    }
                    lsum[qi] += ls;
                }
#pragma unroll
                for (int s2 = 0; s2 < 2; ++s2)
#pragma unroll
                    for (int dt = 0; dt < 2; ++dt) {
                        const bf16x8 vf = *(const bf16x8*)(vp + dt * 32 * 72 + kt * 32 + s2 * 16);
                        O[dt][0] = MFMA(vf, pf[s2][0], O[dt][0]);
                        O[dt][1] = MFMA(vf, pf[s2][1], O[dt][1]);
                    }
            }
        }
        __builtin_amdgcn_sched_barrier(0);
        if (it + 1 < nt) lstore((it + 1) & 1);
        __syncthreads();
    }
}

template <int DQK, bool ALIBI, int NQI>
DI void flash_fixed(const bf16_t* __restrict__ Qg, const bf16_t* __restrict__ Kg, const bf16_t* __restrict__ Vtg, int qbase, int kbeg, int kend,
                    float mfix_, float slope2_, f32x16 (&O)[2][NQI], float (&lsum)[NQI], bf16_t* lds, bool init = true) {
    constexpr int KLD = DQK + 8, NKS = DQK / 16, KCH = DQK / 8, KJ = (64 * KCH) / 256;
    const float mfix = opq(mfix_), slope2 = opq(slope2_);
    const int tid = otid(), lane = tid & 63, w = __builtin_amdgcn_readfirstlane(tid >> 6), ln = lane & 31, hh = lane >> 5;
    const int qw = qbase + w * (32 * NQI);
    bf16x8 qf[NQI][NKS];
#pragma unroll
    for (int qi = 0; qi < NQI; ++qi)
#pragma unroll
        for (int ks = 0; ks < NKS; ++ks) qf[qi][ks] = *(const bf16x8*)(Qg + (size_t)(qw + qi * 32 + ln) * DQK + ks * 16 + hh * 8);
    f32x16 cinit;
#pragma unroll
    for (int i = 0; i < 16; ++i) cinit[i] = -mfix;
    if (init) {
#pragma unroll
    for (int qi = 0; qi < NQI; ++qi) lsum[qi] = 0.f;
#pragma unroll
    for (int a = 0; a < 2; ++a)
#pragma unroll
        for (int b2 = 0; b2 < NQI; ++b2)
#pragma unroll
            for (int i = 0; i < 16; ++i) O[a][b2][i] = 0.f;
    }
    bf16_t* Ks = lds; bf16_t* Vs = lds + 2 * 64 * KLD;
    u32x4 rk[KJ], rv[2];
    auto gload = [&](int key0) {
#pragma unroll
        for (int j = 0; j < KJ; ++j) { const int cidx = tid + 256 * j, row = cidx / KCH, cc = cidx % KCH; rk[j] = *(const u32x4*)(Kg + (size_t)(key0 + row) * DQK + cc * 8); }
#pragma unroll
        for (int j = 0; j < 2; ++j) { const int cidx = tid + 256 * j, row = cidx >> 3, cc = cidx & 7; rv[j] = *(const u32x4*)(Vtg + (size_t)row * SEQ + key0 + cc * 8); }
    };
    auto lstore = [&](int buf) {
#pragma unroll
        for (int j = 0; j < KJ; ++j) { const int cidx = tid + 256 * j, row = cidx / KCH, cc = cidx % KCH; *(u32x4*)(Ks + buf * 64 * KLD + row * KLD + cc * 8) = rk[j]; }
#pragma unroll
        for (int j = 0; j < 2; ++j) { const int cidx = tid + 256 * j, row = cidx >> 3, cc = cidx & 7; *(u32x4*)(Vs + buf * 64 * 72 + row * 72 + cc * 8) = rv[j]; }
    };
    __syncthreads();
    gload(kbeg); lstore(0); __syncthreads();
    const int nt = (kend - kbeg) >> 6;
    for (int it = 0; it < nt; ++it) {
        const int key0 = kbeg + it * 64;
        if (it + 1 < nt) gload(key0 + 64);
        __builtin_amdgcn_sched_barrier(0);
        const int buf = it & 1;
        const bf16_t* kp = Ks + buf * 64 * KLD + ln * KLD + hh * 8;
        const bf16_t* vp = Vs + buf * 64 * 72 + ln * 72 + hh * 8;
#pragma unroll
        for (int kt = 0; kt < 2; ++kt) {
            f32x16 s[NQI];
            const int kb = key0 + kt * 32;
            int side = 0;
            if (ALIBI) {
                side = (kb + 31 < qw) ? 1 : ((kb > qw + 32 * NQI - 1) ? -1 : 0);
                const float fs = (float)side * slope2;
#pragma unroll
                for (int qi = 0; qi < NQI; ++qi) {
                    const float c0 = -mfix - fs * (float)(qw + qi * 32 + ln - (kb + 4 * hh));
#pragma unroll
                    for (int i = 0; i < 16; ++i) s[qi][i] = fmaf(fs, (float)((i & 3) + 8 * (i >> 2)), c0);
                }
            }
#pragma unroll
            for (int ks = 0; ks < NKS; ++ks) {
                const bf16x8 kf = *(const bf16x8*)(kp + kt * 32 * KLD + ks * 16);
#pragma unroll
                for (int qi = 0; qi < NQI; ++qi) s[qi] = (!ALIBI && ks == 0) ? MFMA(kf, qf[qi][0], cinit) : MFMA(kf, qf[qi][ks], s[qi]);
            }
            if (ALIBI) {
                if (side == 0) {
#pragma unroll
                    for (int qi = 0; qi < NQI; ++qi) {
                        const float base = (float)(qw + qi * 32 + ln - (kb + 4 * hh));
#pragma unroll
                        for (int i = 0; i < 16; ++i) s[qi][i] -= slope2 * fabsf(base - (float)((i & 3) + 8 * (i >> 2)));
                    }
                }
            }
            bf16x8 pf[2][NQI];
#pragma unroll
            for (int qi = 0; qi < NQI; ++qi) {
                float ls = 0.f;
#pragma unroll
                for (int i = 0; i < 16; ++i) { const float p = __builtin_amdgcn_exp2f(s[qi][i]); s[qi][i] = p; ls += p; }
#pragma unroll
                for (int s2 = 0; s2 < 2; ++s2) {
                    u32x4 pk;
                    pk.x = pk2(s[qi][8 * s2 + 0], s[qi][8 * s2 + 1]); pk.y = pk2(s[qi][8 * s2 + 2], s[qi][8 * s2 + 3]);
                    pk.z = pk2(s[qi][8 * s2 + 4], s[qi][8 * s2 + 5]); pk.w = pk2(s[qi][8 * s2 + 6], s[qi][8 * s2 + 7]);
                    pf[s2][qi] = __builtin_bit_cast(bf16x8, pk);
                }
                lsum[qi] += ls;
            }
#pragma unroll
            for (int s2 = 0; s2 < 2; ++s2)
#pragma unroll
                for (int dt = 0; dt < 2; ++dt) {
                    const bf16x8 vf = *(const bf16x8*)(vp + dt * 32 * 72 + kt * 32 + s2 * 16);
#pragma unroll
                    for (int qi = 0; qi < NQI; ++qi) O[dt][qi] = MFMA(vf, pf[s2][qi], O[dt][qi]);
                }
        }
        __builtin_amdgcn_sched_barrier(0);
        if (it + 1 < nt) lstore((it + 1) & 1);
        __syncthreads();
    }
}

DI void flash_fixedA(const bf16_t* __restrict__ Qg, const bf16_t* __restrict__ Kg, const bf16_t* __restrict__ Vtg, int qbase, int kbeg, int kend,
                     float mfix_, f32x16 (&O)[2][2], float (&lsum)[2], bf16_t* lds) {
    constexpr int KLD = 72;
    const float mfix = opq(mfix_);
    const int tid = otid(), lane = tid & 63, w = __builtin_amdgcn_readfirstlane(tid >> 6), ln = lane & 31, hh = lane >> 5;
    lsum[0] = 0.f; lsum[1] = 0.f;
#pragma unroll
    for (int a = 0; a < 2; ++a)
#pragma unroll
        for (int b2 = 0; b2 < 2; ++b2)
#pragma unroll
            for (int i = 0; i < 16; ++i) O[a][b2][i] = 0.f;
    bf16_t* Ks = lds; bf16_t* Vs = lds + 2 * 64 * KLD; bf16_t* Qs = lds + 4 * 64 * KLD;
    u32x4 rk[2], rv[2];
    auto gload = [&](int key0) {
#pragma unroll
        for (int j = 0; j < 2; ++j) { const int cidx = tid + 256 * j, row = cidx >> 3, cc = cidx & 7; rk[j] = *(const u32x4*)(Kg + (size_t)(key0 + row) * 64 + cc * 8); rv[j] = *(const u32x4*)(Vtg + (size_t)row * SEQ + key0 + cc * 8); }
    };
    auto lstore = [&](int buf) {
#pragma unroll
        for (int j = 0; j < 2; ++j) { const int cidx = tid + 256 * j, row = cidx >> 3, cc = cidx & 7; *(u32x4*)(Ks + buf * 64 * KLD + row * KLD + cc * 8) = rk[j]; *(u32x4*)(Vs + buf * 64 * 72 + row * 72 + cc * 8) = rv[j]; }
    };
    __syncthreads();
#pragma unroll
    for (int j = 0; j < 8; ++j) { const int cidx = tid + 256 * j, row = cidx >> 3, cc = cidx & 7; *(u32x4*)(Qs + row * KLD + cc * 8) = *(const u32x4*)(Qg + (size_t)(qbase + row) * 64 + cc * 8); }
    gload(kbeg); lstore(0); __syncthreads();
    const bf16_t* qp = Qs + (w * 64 + ln) * KLD + hh * 8;
    const int nt = (kend - kbeg) >> 6;
    for (int it = 0; it < nt; ++it) {
        const int key0 = kbeg + it * 64;
        if (it + 1 < nt) gload(key0 + 64);
        __builtin_amdgcn_sched_barrier(0);
        const int buf = it & 1;
        const bf16_t* kp = Ks + buf * 64 * KLD + ln * KLD + hh * 8;
        const bf16_t* vp = Vs + buf * 64 * 72 + ln * 72 + hh * 8;
        f32x16 s[2][2];
#pragma unroll
        for (int kt = 0; kt < 2; ++kt)
#pragma unroll
            for (int qi = 0; qi < 2; ++qi)
#pragma unroll
                for (int i = 0; i < 16; ++i) s[kt][qi][i] = -mfix;
#pragma unroll
        for (int ks = 0; ks < 4; ++ks) {
            const bf16x8 q0 = *(const bf16x8*)(qp + ks * 16), q1 = *(const bf16x8*)(qp + 32 * KLD + ks * 16);
            const bf16x8 k0 = *(const bf16x8*)(kp + ks * 16), k1 = *(const bf16x8*)(kp + 32 * KLD + ks * 16);
            s[0][0] = MFMA(k0, q0, s[0][0]); s[0][1] = MFMA(k0, q1, s[0][1]);
            s[1][0] = MFMA(k1, q0, s[1][0]); s[1][1] = MFMA(k1, q1, s[1][1]);
        }
#pragma unroll
        for (int kt = 0; kt < 2; ++kt) {
            bf16x8 pf[2][2];
#pragma unroll
            for (int qi = 0; qi < 2; ++qi) {
                float ls = 0.f;
#pragma unroll
                for (int i = 0; i < 16; ++i) { const float p = __builtin_amdgcn_exp2f(s[kt][qi][i]); s[kt][qi][i] = p; ls += p; }
#pragma unroll
                for (int s2 = 0; s2 < 2; ++s2) {
                    u32x4 pk;
                    pk.x = pk2(s[kt][qi][8 * s2 + 0], s[kt][qi][8 * s2 + 1]); pk.y = pk2(s[kt][qi][8 * s2 + 2], s[kt][qi][8 * s2 + 3]);
                    pk.z = pk2(s[kt][qi][8 * s2 + 4], s[kt][qi][8 * s2 + 5]); pk.w = pk2(s[kt][qi][8 * s2 + 6], s[kt][qi][8 * s2 + 7]);
                    pf[s2][qi] = __builtin_bit_cast(bf16x8, pk);
                }
                lsum[qi] += ls;
            }
#pragma unroll
            for (int s2 = 0; s2 < 2; ++s2)
#pragma unroll
                for (int dt = 0; dt < 2; ++dt) {
                    const bf16x8 vf = *(const bf16x8*)(vp + dt * 32 * 72 + kt * 32 + s2 * 16);
                    O[dt][0] = MFMA(vf, pf[s2][0], O[dt][0]);
                    O[dt][1] = MFMA(vf, pf[s2][1], O[dt][1]);
                }
        }
        __builtin_amdgcn_sched_group_barrier(0x008, 16, 0);
        __builtin_amdgcn_sched_group_barrier(0x400, 32, 0);
        __builtin_amdgcn_sched_group_barrier(0x008, 1, 0);
        __builtin_amdgcn_sched_group_barrier(0x400, 4, 0);
        __builtin_amdgcn_sched_group_barrier(0x008, 1, 0);
        __builtin_amdgcn_sched_group_barrier(0x400, 4, 0);
        __builtin_amdgcn_sched_group_barrier(0x008, 1, 0);
        __builtin_amdgcn_sched_group_barrier(0x400, 4, 0);
        __builtin_amdgcn_sched_group_barrier(0x008, 1, 0);
        __builtin_amdgcn_sched_group_barrier(0x400, 4, 0);
        __builtin_amdgcn_sched_group_barrier(0x008, 1, 0);
        __builtin_amdgcn_sched_group_barrier(0x400, 4, 0);
        __builtin_amdgcn_sched_group_barrier(0x008, 1, 0);
        __builtin_amdgcn_sched_group_barrier(0x400, 4, 0);
        __builtin_amdgcn_sched_group_barrier(0x008, 1, 0);
        __builtin_amdgcn_sched_group_barrier(0x400, 4, 0);
        __builtin_amdgcn_sched_group_barrier(0x008, 1, 0);
        __builtin_amdgcn_sched_group_barrier(0x400, 4, 0);
        __builtin_amdgcn_sched_group_barrier(0x008, 8, 0);
        __builtin_amdgcn_sched_barrier(0);
        if (it + 1 < nt) lstore((it + 1) & 1);
        __syncthreads();
    }
}

DI void store_o(const f32x16 (&O)[2][2], const float (&lsum)[2], bf16_t* __restrict__ mixrow0  , int qw) {
    const int lane = otid() & 63, ln = lane & 31, hh = lane >> 5;
#pragma unroll
    for (int qi = 0; qi < 2; ++qi) {
        const float lt = lsum[qi] + __shfl_xor(lsum[qi], 32);
        const float inv = __builtin_amdgcn_rcpf(lt);
        bf16_t* o = mixrow0 + (size_t)(qw + qi * 32 + ln) * DM;
#pragma unroll
        for (int dt = 0; dt < 2; ++dt)
#pragma unroll
            for (int q4 = 0; q4 < 4; ++q4) {
                u32x2 pk; pk.x = pk2(O[dt][qi][q4 * 4 + 0] * inv, O[dt][qi][q4 * 4 + 1] * inv); pk.y = pk2(O[dt][qi][q4 * 4 + 2] * inv, O[dt][qi][q4 * 4 + 3] * inv);
                *(u32x2*)(o + dt * 32 + q4 * 8 + hh * 4) = pk;
            }
    }
}

DI void attn_item_A(int item, const LC& c, bf16_t* lds) {
    const int bh = item >> 6, qblk = item & 63, b = bh >> 2, h = bh & 3, kvh = h >> 1;
    const int lane = otid() & 63;
    float gq = fabsf(c.aqn()[lane]), gk = fabsf(c.akn()[lane]);
#pragma unroll
    for (int o = 32; o > 0; o >>= 1) { gq = fmaxf(gq, __shfl_xor(gq, o)); gk = fmaxf(gk, __shfl_xor(gk, o)); }
    const float smax = 8.0f * gq * gk * LOG2E * 1.01f;
    f32x16 O[2][2]; float ls[2];
    const bf16_t* Q = c.QA() + (size_t)bh * SEQ * 64; const bf16_t* K = c.KA() + (size_t)(b * 2 + kvh) * SEQ * 64; const bf16_t* V = c.VA() + (size_t)(b * 2 + kvh) * 64 * SEQ;
    flash_fixedA(Q, K, V, qblk * 256, 0, SEQ, fminf(smax, 64.0f), O, ls, lds);
    store_o(O, ls, c.MIX() + (size_t)b * SEQ * DM + h * 64, qblk * 256 + __builtin_amdgcn_readfirstlane(otid() >> 6) * 64);
}

DI void attn_item_C(int item, const LC& c, bf16_t* lds) {
    const int bh = item >> 6, rq = item & 63, b = bh >> 2, h = bh & 3;
    const int r0 = rq * 4, kb = min(max(r0 - 4, 0), 248), ke = min(max(r0 + 3 - 4, 0), 248) + 8;
    f32x16 O[2][2]; float ls[2];
    flash_block<64, 2>(c.QC() + (size_t)bh * SEQ * 64, c.KC() + (size_t)bh * SEQ * 64, c.VC() + (size_t)bh * 64 * SEQ, r0 * 64, kb * 64, ke * 64, 0.f, c.rpb() + h * 15 * 31, O, ls, lds);
    store_o(O, ls, c.MIX() + (size_t)b * SEQ * DM + 512 + h * 64, r0 * 64 + __builtin_amdgcn_readfirstlane(otid() >> 6) * 64);
}

DI void attn_item_B(int item, const LC& c, bf16_t* lds) {
    const int bh = item >> 7, qblk = item & 127, b = bh >> 2, h = bh & 3;
    const int tid = otid(), lane = tid & 63, ln = lane & 31, hh = lane >> 5;
    const float slope2 = __builtin_amdgcn_exp2f(-2.0f * (float)(h + 1)) * LOG2E;
    float* st = c.stash() + ((size_t)blockIdx.x * 256 + tid) * 64;
    const bf16_t* Vt = c.VB() + (size_t)bh * 64 * SEQ;
    const int q0 = qblk * 128;
    const int qw = q0 + __builtin_amdgcn_readfirstlane(tid >> 6) * 32;
    const float osc = 1.0f - c.lam_init();
    float lam;
    {
        const float* lq = c.lamp(); const float* lk = c.lamp2();
        float pr = lq[lane] * lk[lane];
        pr = half_sum(pr);
        const float e0 = __shfl(pr, 0), e1 = __shfl(pr, 32);
        lam = __expf(e0) - __expf(e1) + c.lam_init();
    }
#pragma unroll 1
    for (int mp = 0; mp < 2; ++mp) {
        f32x16 O[2][1]; float ls[1];
        const bf16_t* Q = c.QB() + (size_t)(bh * 2 + mp) * SEQ * 32; const bf16_t* K = c.KB() + (size_t)(bh * 2 + mp) * SEQ * 32;
        const float nq2 = __uint_as_float(__hip_atomic_load(c.nmax() + (bh * 2 + mp) * 2, __ATOMIC_RELAXED, __HIP_MEMORY_SCOPE_AGENT));
        const float nk2 = __uint_as_float(__hip_atomic_load(c.nmax() + (bh * 2 + mp) * 2 + 1, __ATOMIC_RELAXED, __HIP_MEMORY_SCOPE_AGENT));
        const float smax = __builtin_amdgcn_sqrtf(nq2 * nk2) * 1.01f;
        const float mfix = fminf(smax, 64.0f);
        const int nw = min(512, max(64, ((int)(24.0f * __builtin_amdgcn_rcpf(slope2)) + 63) & ~63));
        const int nlo = max(0, (q0 - nw) & ~63), nhi = min(SEQ, (q0 + 127 + nw + 64) & ~63);
        flash_fixed<32, true, 1>(Q, K, Vt, q0, nlo, nhi, mfix, slope2, O, ls, lds, true);
        float lm = ls[0] + __shfl_xor(ls[0], 32);
#pragma unroll
        for (int o = 16; o > 0; o >>= 1) lm = fminf(lm, __shfl_xor(lm, o));
        float* red = (float*)lds + 18000;
        __syncthreads();
        if (lane == 0) red[__builtin_amdgcn_readfirstlane(tid >> 6)] = lm;
        __syncthreads();
        const float lmin = fminf(fminf(red[0], red[1]), fminf(red[2], red[3]));
        const float need = 26.0f + __builtin_amdgcn_logf(2.0f * __builtin_amdgcn_rcpf(1.0f - __builtin_amdgcn_exp2f(-slope2))) * 1.01f + 0.5f + (smax - mfix) - __builtin_amdgcn_logf(lmin);
        const int dwin = (int)fminf(fmaxf(need, 0.f) * __builtin_amdgcn_rcpf(slope2) * 1.001f + 2.0f, 32768.0f);
        const int kb0 = max(0, (q0 - dwin) & ~63), ke0 = min(SEQ, (q0 + 127 + dwin + 64) & ~63);
        if (kb0 < nlo) flash_fixed<32, true, 1>(Q, K, Vt, q0, kb0, nlo, mfix, slope2, O, ls, lds, false);
        if (ke0 > nhi) flash_fixed<32, true, 1>(Q, K, Vt, q0, nhi, ke0, mfix, slope2, O, ls, lds, false);
        if (mp == 0) {
            const float inv = __builtin_amdgcn_rcpf(ls[0] + __shfl_xor(ls[0], 32));
#pragma unroll
            for (int dt = 0; dt < 2; ++dt)
#pragma unroll
                for (int q4 = 0; q4 < 4; ++q4) {
                    f32x4 v = {O[dt][0][q4 * 4] * inv, O[dt][0][q4 * 4 + 1] * inv, O[dt][0][q4 * 4 + 2] * inv, O[dt][0][q4 * 4 + 3] * inv};
                    *(f32x4*)(st + dt * 16 + q4 * 4) = v;
                }
        } else {
            const float inv = lam * __builtin_amdgcn_rcpf(ls[0] + __shfl_xor(ls[0], 32));
            float ss = 0.f;
#pragma unroll
            for (int dt = 0; dt < 2; ++dt)
#pragma unroll
                for (int q4 = 0; q4 < 4; ++q4) {
                    const f32x4 v = *(const f32x4*)(st + dt * 16 + q4 * 4);
#pragma unroll
                    for (int j = 0; j < 4; ++j) { const float a = v[j] - O[dt][0][q4 * 4 + j] * inv; O[dt][0][q4 * 4 + j] = a; ss += a * a; }
                }
            ss += __shfl_xor(ss, 32);
            const float rn = __builtin_amdgcn_rsqf(ss * (1.0f / 64.0f) + 1e-6f) * osc;
            bf16_t* o = c.MIX() + ((size_t)b * SEQ + qw + ln) * DM + 256 + h * 64;
#pragma unroll
            for (int dt = 0; dt < 2; ++dt)
#pragma unroll
                for (int q4 = 0; q4 < 4; ++q4) {
                    const int d = dt * 32 + q4 * 8 + hh * 4;
                    const f32x4 g = *(const f32x4*)(c.bsub() + d);
                    u32x2 pk; pk.x = pk2(O[dt][0][q4 * 4 + 0] * rn * g[0], O[dt][0][q4 * 4 + 1] * rn * g[1]); pk.y = pk2(O[dt][0][q4 * 4 + 2] * rn * g[2], O[dt][0][q4 * 4 + 3] * rn * g[3]);
                    *(u32x2*)(o + d) = pk;
                }
        }
    }
}

DI void sgu_item(int item, const LC& c, bf16_t* lds) {
    constexpr int TLD = 136;
    const int tid = otid(), lane = tid & 63, w = __builtin_amdgcn_readfirstlane(tid >> 6), ln = lane & 31, hh = lane >> 5;
    const size_t t0 = (size_t)item * 128;
    __syncthreads();
    {
        const int tok = tid >> 1, half = tid & 1;
        const bf16_t* src = c.VD() + (t0 + tok) * 256 + half * 128;
        float sum = 0.f, sq = 0.f;
#pragma unroll 4
        for (int j = 0; j < 16; ++j) {
            const u32x4 raw = *(const u32x4*)(src + j * 8);
#pragma unroll
            for (int e = 0; e < 4; ++e) { const float a = __uint_as_float(raw[e] << 16), b2 = __uint_as_float(raw[e] & 0xffff0000u); sum += a + b2; sq += a * a + b2 * b2; }
        }
        sum += __shfl_xor(sum, 1); sq += __shfl_xor(sq, 1);
        const float mean = sum * (1.0f / 256.0f);
        const float rstd = __builtin_amdgcn_rsqf(fmaxf(sq * (1.0f / 256.0f) - mean * mean, 0.f) + 1e-5f);
#pragma unroll 2
        for (int j = 0; j < 16; ++j) {
            const u32x4 raw = *(const u32x4*)(src + j * 8);
#pragma unroll
            for (int e = 0; e < 4; ++e) {
                const int col = half * 128 + j * 8 + e * 2;
                const float a = (__uint_as_float(raw[e] << 16) - mean) * rstd * c.lng()[col] + c.lnb()[col];
                const float b2 = (__uint_as_float(raw[e] & 0xffff0000u) - mean) * rstd * c.lng()[col + 1] + c.lnb()[col + 1];
                lds[col * TLD + tok] = f2bf(a); lds[(col + 1) * TLD + tok] = f2bf(b2);
            }
        }
    }
    __syncthreads();
    const int g = w;
    const float* Wg = c.wsf() + (size_t)g * 128 * 128;
#pragma unroll 1
    for (int mh = 0; mh < 2; ++mh) {
        f32x16 acc[2][2];
#pragma unroll
        for (int a = 0; a < 2; ++a)
#pragma unroll
            for (int b2 = 0; b2 < 2; ++b2)
#pragma unroll
                for (int i = 0; i < 16; ++i) acc[a][b2][i] = 0.f;
#pragma unroll
        for (int ks = 0; ks < 8; ++ks) {
            bf16x8 a0, a1;
            {
                const float* p0 = Wg + (size_t)(mh * 64 + ln) * 128 + ks * 16 + hh * 8; const float* p1 = p0 + 32 * 128;
                const f32x4 x0 = *(const f32x4*)p0, x1 = *(const f32x4*)(p0 + 4), y0 = *(const f32x4*)p1, y1 = *(const f32x4*)(p1 + 4);
                u32x4 pa, pb;
                pa.x = pk2(x0[0], x0[1]); pa.y = pk2(x0[2], x0[3]); pa.z = pk2(x1[0], x1[1]); pa.w = pk2(x1[2], x1[3]);
                pb.x = pk2(y0[0], y0[1]); pb.y = pk2(y0[2], y0[3]); pb.z = pk2(y1[0], y1[1]); pb.w = pk2(y1[2], y1[3]);
                a0 = __builtin_bit_cast(bf16x8, pa); a1 = __builtin_bit_cast(bf16x8, pb);
            }
            const bf16x8 b0 = *(const bf16x8*)(lds + (g * 64 + ln) * TLD + ks * 16 + hh * 8);
            const bf16x8 b1 = *(const bf16x8*)(lds + (g * 64 + 32 + ln) * TLD + ks * 16 + hh * 8);
            acc[0][0] = MFMA(a0, b0, acc[0][0]); acc[0][1] = MFMA(a0, b1, acc[0][1]);
            acc[1][0] = MFMA(a1, b0, acc[1][0]); acc[1][1] = MFMA(a1, b1, acc[1][1]);
        }
        const bf16_t* ud = c.UD(); bf16_t* mixp = c.MIX();
        float uv[2][16][2];
#pragma unroll
        for (int mi = 0; mi < 2; ++mi)
#pragma unroll
            for (int i = 0; i < 16; ++i) {
                const int t = mh * 64 + mi * 32 + crow(i, hh);
#pragma unroll
                for (int ni = 0; ni < 2; ++ni) uv[mi][i][ni] = bf2f(ud[(t0 + t) * 256 + g * 64 + ni * 32 + ln]);
            }
        __builtin_amdgcn_sched_barrier(0);
#pragma unroll
        for (int mi = 0; mi < 2; ++mi)
#pragma unroll
            for (int i = 0; i < 16; ++i) {
                const int t = mh * 64 + mi * 32 + crow(i, hh);
                const float bsv = c.bs()[g * 128 + t];
#pragma unroll
                for (int ni = 0; ni < 2; ++ni) mixp[(t0 + t) * DM + 768 + g * 64 + ni * 32 + ln] = f2bf(uv[mi][i][ni] * (acc[mi][ni][i] + bsv));
            }
    }
}

DI void conv_weight(const float* __restrict__ W, int K, int N, const float* __restrict__ g, bf16_t* __restrict__ Wt, int nmode, float* tile, int vb, int G) {
    const int tid = otid();
    const int tk = K >> 6, tn = N >> 6;
    for (int t = vb; t < tk * tn; t += G) {
        const int k0 = (t / tn) * 64, n0 = (t % tn) * 64;
        __syncthreads();
#pragma unroll
        for (int j = 0; j < 4; ++j) {
            const int idx = tid + 256 * j, r = idx >> 4, c4 = idx & 15;
            f32x4 v = *(const f32x4*)(W + (size_t)(k0 + r) * N + n0 + c4 * 4);
            const float sc = g ? g[k0 + r] : 1.0f;
            tile[r * 65 + c4 * 4 + 0] = v[0] * sc; tile[r * 65 + c4 * 4 + 1] = v[1] * sc; tile[r * 65 + c4 * 4 + 2] = v[2] * sc; tile[r * 65 + c4 * 4 + 3] = v[3] * sc;
        }
        __syncthreads();
#pragma unroll
        for (int j = 0; j < 2; ++j) {
            const int idx = tid + 256 * j, n = idx >> 3, kc = (idx & 7) * 8;
            u32x4 pk;
            pk.x = pk2(tile[(kc + 0) * 65 + n], tile[(kc + 1) * 65 + n]); pk.y = pk2(tile[(kc + 2) * 65 + n], tile[(kc + 3) * 65 + n]);
            pk.z = pk2(tile[(kc + 4) * 65 + n], tile[(kc + 5) * 65 + n]); pk.w = pk2(tile[(kc + 6) * 65 + n], tile[(kc + 7) * 65 + n]);
            const int ng = n0 + n;
            const int np = nmode == 0 ? ng : ((ng >> 5) * 64 + (nmode == 2 ? 32 : 0) + (ng & 31));
            *(u32x4*)(Wt + (size_t)np * K + k0 + kc) = pk;
        }
    }
}

#define XB_TMO      128
#define XB_XCNT(j)  (256  + 64 * (j))
#define XB_XSUB(j)  (1280 + 64 * (j))
#define XB_XGEN(j)  (2304 + 64 * (j))
#define XB_TOP      3328
#define XB_TOPGEN   3392
#define XCD_BAR_WORDS 3456
#define XB_SPIN_CAP (1u << 18)
#define LAS __attribute__((address_space(3)))
DI unsigned xb_ld(unsigned* p)              { return __hip_atomic_load(p, __ATOMIC_RELAXED, __HIP_MEMORY_SCOPE_AGENT); }
DI unsigned xb_add(unsigned* p, unsigned v) { return __hip_atomic_fetch_add(p, v, __ATOMIC_RELAXED, __HIP_MEMORY_SCOPE_AGENT); }
DI unsigned xb_xcc_id() { return (unsigned)__builtin_amdgcn_s_getreg((3 << 11) | 20) & 0xFu; }
#define XB_SPIN(cond, bar) do { unsigned _sp = 0; while (cond) { __builtin_amdgcn_s_sleep(1); \
    if ((++_sp & 255u) == 0u) { if (xb_ld(&(bar)[XB_TMO])) break; if (_sp > XB_SPIN_CAP) { atomicAdd(&(bar)[XB_TMO], 1u); break; } } } } while (0)
struct XcdBarrier { unsigned* bar; unsigned x; volatile LAS unsigned* st; };
DI XcdBarrier xcd_barrier_post(unsigned* bar, volatile LAS unsigned* st) {
    XcdBarrier b; b.bar = bar; b.x = xb_xcc_id(); b.st = st;
    if (threadIdx.x == 0) (void)xb_add(&bar[XB_XCNT(b.x)], 1u);
    return b;
}
DI void xcd_barrier_complete(unsigned* bar, unsigned x, unsigned& nloc, unsigned& nx) {
    const unsigned G = gridDim.x * gridDim.y * gridDim.z;
    unsigned sum, cnt, mine, sp = 0u;
    for (;;) {
        sum = 0u; cnt = 0u; mine = 0u;
#pragma unroll
        for (unsigned j = 0; j < 16; ++j) { const unsigned c = xb_ld(&bar[XB_XCNT(j)]); sum += c; cnt += (c > 0u) ? 1u : 0u; mine = (j == x) ? c : mine; }
        if (sum == G) break;
        __builtin_amdgcn_s_sleep(1);
        if ((++sp & 255u) == 0u) { if (xb_ld(&bar[XB_TMO])) break; if (sp > XB_SPIN_CAP) { atomicAdd(&bar[XB_TMO], 1u); break; } }
    }
    nloc = mine > 0u ? mine : 1u; nx = cnt > 0u ? cnt : 1u;
}
DI void xcd_barrier(const XcdBarrier& b) {
    asm volatile("s_waitcnt vmcnt(0)" ::: "memory");
    __syncthreads();
    if (threadIdx.x == 0) {
        unsigned* bar = b.bar;
        __builtin_amdgcn_s_waitcnt(0);
        unsigned nloc = b.st[0], nx = b.st[1];
        if (nloc == 0u) { xcd_barrier_complete(bar, b.x, nloc, nx); b.st[0] = nloc; b.st[1] = nx; }
        const unsigned old = xb_add(&bar[XB_XSUB(b.x)], 1u);
        const unsigned gen = old / nloc;
        if (old + 1u == (gen + 1u) * nloc) {
            __builtin_amdgcn_fence(__ATOMIC_RELEASE, "agent");
            asm volatile("s_waitcnt vmcnt(0)" ::: "memory");
            const unsigned og = xb_add(&bar[XB_TOP], 1u);
            const unsigned tg = og / nx;
            if (og + 1u == (tg + 1u) * nx) xb_add(&bar[XB_TOPGEN], 1u);
            else XB_SPIN(xb_ld(&bar[XB_TOPGEN]) == tg, bar);
            __builtin_amdgcn_fence(__ATOMIC_ACQUIRE, "agent");
            xb_add(&bar[XB_XGEN(b.x)], 1u);
            asm volatile("s_waitcnt vmcnt(0)" ::: "memory");
        } else {
            XB_SPIN(xb_ld(&bar[XB_XGEN(b.x)]) == gen, bar);
            __builtin_amdgcn_fence(__ATOMIC_ACQUIRE, "agent");
            asm volatile("s_waitcnt vmcnt(0)" ::: "memory");
        }
    }
    __syncthreads();
}

DI int take_tile(unsigned* q, int per_q, int home, int& tried, volatile int* sh) {
    __syncthreads();
    if (otid() == 0) {
        int t = -1;
        while (tried < 8) {
            const int qi = (home + tried) & 7;
            const unsigned v = __hip_atomic_fetch_add(q + qi * 16, 1u, __ATOMIC_RELAXED, __HIP_MEMORY_SCOPE_AGENT);
            if (v < (unsigned)per_q) { t = qi * per_q + (int)v; break; }
            ++tried;
        }
        *sh = t;
    }
    __syncthreads();
    return *sh;
}

DI void gsync(cg::grid_group& grid) { __threadfence(); grid.sync(); __threadfence(); }

__global__ void __launch_bounds__(256, 2) fwd_megakernel(KP P) {
    cg::grid_group grid = cg::this_grid();
    __shared__ __attribute__((aligned(16))) bf16_t lds[LDS_BYTES / 2];
    __shared__ int sh_item;
    __shared__ uint4 xb_words;
    if (threadIdx.x == 0) xb_words = make_uint4(0u, 0u, 0u, 0u);
    __syncthreads();
    const XcdBarrier xb = xcd_barrier_post((unsigned*)(P.ws + OFF_ROPE), (volatile LAS unsigned*)&xb_words);
    const int tid = otid(), lane = tid & 63, w = __builtin_amdgcn_readfirstlane(tid >> 6);
    const int G = gridDim.x, bid = blockIdx.x;
    const int vb = (G & 7) == 0 ? ((bid & 7) * (G >> 3) + (bid >> 3)) : bid;
    unsigned char* ws = P.ws;
    bf16_t* Wb = (bf16_t*)(ws + OFF_W);
    bf16_t* hb0 = (bf16_t*)(ws + OFF_HB0);
    bf16_t* hb1 = (bf16_t*)(ws + OFF_HB1);
    unsigned char* R = ws + OFF_R;
    float* rowss = (float*)(ws + OFF_ROWSS);
    unsigned* ctl = (unsigned*)(ws + OFF_WS);
    unsigned* qcnt = ctl + 128;

    for (int l = 0; l < DEPTH; ++l) {
        bf16_t* wl = Wb + (size_t)l * WL_TOT;
        float* tile = (float*)lds;
        conv_weight(P.in[3] + (size_t)l * DM * PROJ, DM, PROJ, P.in[2] + l * DM, wl + WL_IN, 0, tile, vb, G);
        conv_weight(P.in[14] + (size_t)l * DM * DM, DM, DM, nullptr, wl + WL_OUT, 0, tile, vb, G);
        conv_weight(P.in[16] + (size_t)l * DM * FFN, DM, FFN, P.in[15] + l * DM, wl + WL_GU, 1, tile, vb, G);
        conv_weight(P.in[17] + (size_t)l * DM * FFN, DM, FFN, P.in[15] + l * DM, wl + WL_GU, 2, tile, vb, G);
        conv_weight(P.in[18] + (size_t)l * FFN * DM, FFN, DM, nullptr, wl + WL_DOWN, 0, tile, vb, G);
        conv_weight(P.in[20] + (size_t)l * DM * DM, DM, DM, P.in[19] + l * DM, wl + WL_PG, 0, tile, vb, G);
        conv_weight(P.in[21] + (size_t)l * PLE * DM, PLE, DM, nullptr, wl + WL_PP, 0, tile, vb, G);
    }
    {
        const float* x = P.in[0];
        for (int row = bid * 4 + w; row < NTOK; row += G * 4) {
            float ss = 0.f;
#pragma unroll
            for (int j = 0; j < 4; ++j) {
                const f32x4 v = *(const f32x4*)(x + (size_t)row * DM + j * 256 + lane * 4);
                ss += v[0] * v[0] + v[1] * v[1] + v[2] * v[2] + v[3] * v[3];
                u32x2 pk; pk.x = pk2(v[0], v[1]); pk.y = pk2(v[2], v[3]);
                *(u32x2*)(hb0 + (size_t)row * DM + j * 256 + lane * 4) = pk;
            }
#pragma unroll
            for (int o = 32; o > 0; o >>= 1) ss += __shfl_xor(ss, o);
            if (lane < 8) rowss[(size_t)row * 8 + lane] = lane == 0 ? ss : 0.f;
        }
    }
    if (bid == 0) for (int i = tid; i < 256 + 4 * 5 * 128; i += 256) ctl[i] = 0u;
    gsync(grid);

    bf16_t* hb_cur = hb0; bf16_t* hb_alt = hb1;
    for (int l = 0; l < DEPTH; ++l) {
        LC c; c.P = &P; c.ws = ws; c.hb_cur = hb_cur; c.hb_alt = hb_alt; c.l = l; c.pad_ = 0;
        for (int tried_ = 0;;) {
            const int t = take_tile(ctl + 256 + (l * 5 + 0) * 128, 2560 / 8, (int)xb.x & 7, tried_, &sh_item); if (t < 0) break;
            const int m0 = ((t / 160) * 8 + (t & 7)) * 256, n0 = ((t % 160) >> 3) * 128;
            const float rpre0 = rstd_pre(c.rs_mix(), m0), rpre1 = rstd_pre(c.rs_mix(), m0 + 128);
            f32x16 acc[4][2];
            gemm_kloop256(c.hb_cur, DM, c.w_in(), DM, DM, m0, n0, acc, lds);
            rstd_put(rpre0, (float*)lds);
            epi_proj(*(const f32x16 (*)[2][2])&acc[0], m0, n0, c, (const float*)lds, lds);
            __syncthreads();
            rstd_put(rpre1, (float*)lds);
            epi_proj(*(const f32x16 (*)[2][2])&acc[2], m0 + 128, n0, c, (const float*)lds, lds);
        }
        xcd_barrier(xb);
        for (;;) {
            __syncthreads();
            if (otid() == 0) sh_item = (int)atomicAdd(qcnt + l, 1u);
            __syncthreads();
            const int t = sh_item;
            if (t >= 2304) break;
            if (t < 512) attn_item_A(t, c, lds);
            else if (t < 768) { const int u = t - 512; attn_item_B(((u >> 7) * 4 + 3) * 128 + (u & 127), c, lds); }
            else if (t < 1536) { const int u = t - 768, hd = 2 - (u >> 8), v = u & 255; attn_item_B(((v >> 7) * 4 + hd) * 128 + (v & 127), c, lds); }
            else if (t < 2048) attn_item_C(t - 1536, c, lds);
            else sgu_item(t - 2048, c, lds);
        }
        xcd_barrier(xb);
        for (int tried_ = 0;;) {
            const int t = take_tile(ctl + 256 + (l * 5 + 1) * 128, 1024 / 8, (int)xb.x & 7, tried_, &sh_item); if (t < 0) break;
            const int m0 = ((t >> 6) * 8 + (t & 7)) * 256, n0 = ((t & 63) >> 3) * 128;
            f32x16 acc[4][2];
            gemm_kloop256(c.MIX(), DM, c.w_out(), DM, DM, m0, n0, acc, lds);
            epi_resid(*(const f32x16 (*)[2][2])&acc[0], m0, n0, c.hb_cur, c.hb_cur, c.rs_ffn(), lds);
            __syncthreads();
            epi_resid(*(const f32x16 (*)[2][2])&acc[2], m0 + 128, n0, c.hb_cur, c.hb_cur, c.rs_ffn(), lds);
        }
        xcd_barrier(xb);
        for (int tried_ = 0;;) {
            const int t = take_tile(ctl + 256 + (l * 5 + 2) * 128, 5632 / 8, (int)xb.x & 7, tried_, &sh_item); if (t < 0) break;
            const int m0 = ((t / 352) * 8 + (t & 7)) * 256, n0 = ((t % 352) >> 3) * 128;
            const float rpre0 = rstd_pre(c.rs_ffn(), m0), rpre1 = rstd_pre(c.rs_ffn(), m0 + 128);
            f32x16 acc[4][2];
            gemm_kloop256(c.hb_cur, DM, c.w_gu(), DM, DM, m0, n0, acc, lds);
            rstd_put(rpre0, (float*)lds);
            epi_swiglu(*(const f32x16 (*)[2][2])&acc[0], m0, n0, (const float*)lds, c.ACT(), lds);
            __syncthreads();
            rstd_put(rpre1, (float*)lds);
            epi_swiglu(*(const f32x16 (*)[2][2])&acc[2], m0 + 128, n0, (const float*)lds, c.ACT(), lds);
        }
        xcd_barrier(xb);
        for (int tried_ = 0;;) {
            const int t = take_tile(ctl + 256 + (l * 5 + 3) * 128, 1024 / 8, (int)xb.x & 7, tried_, &sh_item); if (t < 0) break;
            const int m0 = ((t >> 6) * 8 + (t & 7)) * 256, n0 = ((t & 63) >> 3) * 128;
            f32x16 acc[4][2];
            gemm_kloop256(c.ACT(), FFN, c.w_down(), FFN, FFN, m0, n0, acc, lds);
            epi_resid(*(const f32x16 (*)[2][2])&acc[0], m0, n0, c.hb_cur, c.hb_cur, c.rs_ple(), lds);
            __syncthreads();
            epi_resid(*(const f32x16 (*)[2][2])&acc[2], m0 + 128, n0, c.hb_cur, c.hb_cur, c.rs_ple(), lds);
        }
        xcd_barrier(xb);
            for (int tried_ = 0;;) { const int t = take_tile(ctl + 256 + (l * 5 + 4) * 128, 2048 / 8, (int)xb.x & 7, tried_, &sh_item); if (t < 0) break;

            const int m0 = ((t >> 6) * 8 + (t & 7)) * 128, n0 = ((t & 63) >> 3) * 128;
            f32x16 acc[2][2];
            {
                const float rpre = rstd_pre(c.rs_ple(), m0);
                f32x16 gacc[2][2];
                { u32x4 ra[4], rb[4]; gemm_kloop<false>(c.hb_cur, DM, c.w_pg(), DM, DM, m0, n0, gacc, lds, ra, rb, false, false, 0, 0); }
                rstd_put(rpre, (float*)lds);
                epi_gate_stage(gacc, (const float*)lds, lds);
            }
            gemm_kloop_p(c.p(), c.w_pp(), m0, n0, acc, lds);
            epi_gate_apply(acc, lds);
            __syncthreads();
            epi_resid(acc, m0, n0, c.hb_cur, c.hb_alt, c.rs_next(), lds);
        }
        xcd_barrier(xb);
        { bf16_t* tmp = hb_cur; hb_cur = hb_alt; hb_alt = tmp; }
    }
    {
        const float* gf = P.in[22];
        const float* rsf = rowss;
        const int tid2 = otid(), lane = tid2 & 63, w = __builtin_amdgcn_readfirstlane(tid2 >> 6);
        for (int row = bid * 4 + w; row < NTOK; row += G * 4) {
            float sm = 0.f;
            { const f32x4 a = *(const f32x4*)(rsf + (size_t)row * 8), b2 = *(const f32x4*)(rsf + (size_t)row * 8 + 4);
              sm = ((a[0] + a[1]) + (a[2] + a[3])) + ((b2[0] + b2[1]) + (b2[2] + b2[3])); }
            const float rstd = __builtin_amdgcn_rsqf(sm * (1.0f / DM) + 1e-6f);
#pragma unroll
            for (int j = 0; j < 2; ++j) {
                const int col = j * 512 + lane * 8;
                const u32x4 v = *(const u32x4*)(hb_cur + (size_t)row * DM + col);
                const f32x4 g0 = *(const f32x4*)(gf + col), g1 = *(const f32x4*)(gf + col + 4);
                f32x4 o0, o1;
                o0[0] = __uint_as_float(v.x << 16) * rstd * g0[0]; o0[1] = __uint_as_float(v.x & 0xffff0000u) * rstd * g0[1];
                o0[2] = __uint_as_float(v.y << 16) * rstd * g0[2]; o0[3] = __uint_as_float(v.y & 0xffff0000u) * rstd * g0[3];
                o1[0] = __uint_as_float(v.z << 16) * rstd * g1[0]; o1[1] = __uint_as_float(v.z & 0xffff0000u) * rstd * g1[1];
                o1[2] = __uint_as_float(v.w << 16) * rstd * g1[2]; o1[3] = __uint_as_float(v.w & 0xffff0000u) * rstd * g1[3];
                *(f32x4*)(P.out + (size_t)row * DM + col) = o0; *(f32x4*)(P.out + (size_t)row * DM + col + 4) = o1;
            }
        }
    }
}

extern "C" void kernel_launch(void* const* d_in, const int* in_sizes, int n_in, void* d_out, int out_size, void* d_ws, size_t ws_size, hipStream_t stream) {
    static int grid_blocks = 0;
    if (!grid_blocks) {
        int dev = 0, cus = 0, per_cu = 0;
        hipGetDevice(&dev);
        hipDeviceGetAttribute(&cus, hipDeviceAttributeMultiprocessorCount, dev);
        hipOccupancyMaxActiveBlocksPerMultiprocessor(&per_cu, fwd_megakernel, 256, 0);
        if (per_cu > 2) per_cu = 2;
        grid_blocks = cus * per_cu;
    }
    hipMemsetAsync((char*)d_ws + OFF_ROPE, 0, XCD_BAR_WORDS * sizeof(unsigned), stream);
    KP p{};
    for (int i = 0; i < 23; ++i) p.in[i] = (const float*)d_in[i];
    p.out = (float*)d_out; p.ws = (unsigned char*)d_ws;
    void* args[] = {&p};
    hipError_t e = hipLaunchCooperativeKernel((void*)fwd_megakernel, dim3(grid_blocks), dim3(256), args, 0, stream);
    if (e != hipSuccess) fprintf(stderr, "cooperative launch failed: %s (grid %d)\n", hipGetErrorString(e), grid_blocks);
}
```
